# Optimizing an MI355X kernel written in HIP

```python
import jax, jax.numpy as jnp
from jax import lax
import numpy as np

D_MODEL = 4096
BATCH = 32
SEQ = 256
DEPTH = 1
DEC_BATCH = 2
DEC_SEQ = 1024
PAST_LEN = 256

GRID_W = 64
N_HEADS = 16
QK_NOPE_DIM = 128
QK_ROPE_DIM = 64
V_HEAD_DIM = 128
Q_LORA_RANK = 1024
KV_LORA_RANK = 512
MLA_WIDTH = N_HEADS * V_HEAD_DIM
POOL_WIDTH = D_MODEL - MLA_WIDTH
POOL_WINDOWS = (2, 4, 8, 16)
N_POOL_GROUPS = len(POOL_WINDOWS)
POOL_GROUP_DIM = POOL_WIDTH // N_POOL_GROUPS
IN_PROJ_DIM = Q_LORA_RANK + KV_LORA_RANK + QK_ROPE_DIM + POOL_WIDTH
D_FF = 11008
ROPE_THETA = 10000.0
LN_EPS = 1e-5
RMS_EPS = 1e-6
Q_BLOCK = 128
N_MOD = 9
DEEPNORM_ALPHA = (2.0 * DEPTH) ** 0.25
DEEPNORM_BETA = (8.0 * DEPTH) ** -0.25
ATTN_SCALE = (QK_NOPE_DIM + QK_ROPE_DIM) ** -0.5

kernel_name = "hybrid_mla_pool_diffusion_step"


def _plain_ln(x):
    xf = x.astype(jnp.float32)
    mu = jnp.mean(xf, -1, keepdims=True)
    var = jnp.mean(jnp.square(xf - mu), -1, keepdims=True)
    return ((xf - mu) * lax.rsqrt(var + LN_EPS)).astype(x.dtype)


def _affine_ln(x, gamma, beta):
    xf = x.astype(jnp.float32)
    mu = jnp.mean(xf, -1, keepdims=True)
    var = jnp.mean(jnp.square(xf - mu), -1, keepdims=True)
    y = (xf - mu) * lax.rsqrt(var + LN_EPS) * gamma.astype(jnp.float32) + beta.astype(jnp.float32)
    return y.astype(x.dtype)


def _rms_norm(x, g):
    xf = x.astype(jnp.float32)
    y = xf * lax.rsqrt(jnp.mean(jnp.square(xf), -1, keepdims=True) + RMS_EPS)
    return (y * g.astype(jnp.float32)).astype(x.dtype)


def _modulation(cond, w_ada, b_ada):
    m = (jax.nn.silu(cond) @ w_ada + b_ada)[:, None, :]
    return jnp.split(m, N_MOD, axis=-1)


def _modulate(x, shift, scale):
    return _plain_ln(x) * (1.0 + scale) + shift


def _post_norm(x, delta, gamma, beta):
    return _affine_ln(DEEPNORM_ALPHA * x + delta, gamma, beta)


def _swiglu(u, w_gate, w_up, w_down):
    return (jax.nn.silu(u @ w_gate) * (u @ w_up)) @ w_down


def _axial_rope(n_tokens):
    rows = n_tokens // GRID_W
    row_id = jnp.repeat(jnp.arange(rows, dtype=jnp.float32), GRID_W)
    col_id = jnp.tile(jnp.arange(GRID_W, dtype=jnp.float32), rows)
    n_freq = QK_ROPE_DIM // 4
    inv_freq = ROPE_THETA ** (-jnp.arange(n_freq, dtype=jnp.float32) / n_freq)
    ang = jnp.concatenate([row_id[:, None] * inv_freq, col_id[:, None] * inv_freq], -1)
    return jnp.cos(ang), jnp.sin(ang)


def _apply_rope(x, cos, sin):
    xf = x.astype(jnp.float32)
    x1, x2 = xf[..., :QK_ROPE_DIM // 2], xf[..., QK_ROPE_DIM // 2:]
    return jnp.concatenate([x1 * cos - x2 * sin, x1 * sin + x2 * cos], -1).astype(x.dtype)


def _split_in_proj(h):
    i0 = Q_LORA_RANK
    i1 = i0 + KV_LORA_RANK
    i2 = i1 + QK_ROPE_DIM
    return h[..., :i0], h[..., i0:i1], h[..., i1:i2], h[..., i2:]


def _mla_queries(c_q, g_q, w_uq):
    b, t, _ = c_q.shape
    q = (_rms_norm(c_q, g_q) @ w_uq).reshape(b, t, N_HEADS, QK_NOPE_DIM + QK_ROPE_DIM)
    return q[..., :QK_NOPE_DIM], q[..., QK_NOPE_DIM:]


def _mla_keys_values(c_kv, w_ukv):
    b, l, _ = c_kv.shape
    kv = (c_kv @ w_ukv).reshape(b, l, N_HEADS, QK_NOPE_DIM + V_HEAD_DIM)
    return kv[..., :QK_NOPE_DIM], kv[..., QK_NOPE_DIM:]


def _mla_attention(q_nope, q_rope, k_nope, k_rope, v):
    b, t, h, _ = q_nope.shape
    nb = t // Q_BLOCK
    qn = q_nope.reshape(b, nb, Q_BLOCK, h, QK_NOPE_DIM).transpose(1, 0, 2, 3, 4)
    qr = q_rope.reshape(b, nb, Q_BLOCK, h, QK_ROPE_DIM).transpose(1, 0, 2, 3, 4)

    def one_block(args):
        qn_b, qr_b = args
        s = (jnp.einsum("bqhd,bkhd->bhqk", qn_b, k_nope)
             + jnp.einsum("bqhd,bkd->bhqk", qr_b, k_rope))
        p = jax.nn.softmax(s.astype(jnp.float32) * ATTN_SCALE, axis=-1).astype(v.dtype)
        return jnp.einsum("bhqk,bkhd->bqhd", p, v)

    out = lax.map(one_block, (qn, qr))
    return out.transpose(1, 0, 2, 3, 4).reshape(b, t, h * V_HEAD_DIM)


def _multiscale_pool(x_pool, w_pool, pool_scale):
    b, t, _ = x_pool.shape
    xg = x_pool.reshape(b, t, N_POOL_GROUPS, POOL_GROUP_DIM)
    csum = jnp.cumsum(xg.astype(jnp.float32), axis=1)
    csum = jnp.pad(csum, ((0, 0), (1, 0), (0, 0), (0, 0)))
    pos = jnp.arange(t)
    half = jnp.array(POOL_WINDOWS, dtype=jnp.int32) // 2
    lo = jnp.clip(pos[:, None] - half[None, :], 0, t)
    hi = jnp.clip(pos[:, None] + half[None, :], 0, t)
    g_idx = jnp.arange(N_POOL_GROUPS)[None, :]
    win_sum = csum[:, hi, g_idx, :] - csum[:, lo, g_idx, :]
    count = (hi - lo).astype(jnp.float32)[None, :, :, None]
    pooled = (win_sum / count).astype(x_pool.dtype) - xg
    mixed = jnp.einsum("btgd,gde->btge", pooled, w_pool).reshape(b, t, POOL_WIDTH)
    return mixed * pool_scale


def _context_mixer(u, w_in, g_q, w_uq, g_kv, w_ukv, w_pool, pool_scale, w_out):
    c_q, c_kv, k_rope, x_pool = _split_in_proj(u @ w_in)
    c_kv = _rms_norm(c_kv, g_kv)
    q_nope, q_rope = _mla_queries(c_q, g_q, w_uq)
    k_nope, v = _mla_keys_values(c_kv, w_ukv)
    attn = _mla_attention(q_nope, q_rope, k_nope, k_rope, v)
    pool = _multiscale_pool(x_pool, w_pool, pool_scale)
    return jnp.concatenate([attn, pool], -1) @ w_out, (c_kv, k_rope)


def _latent_mixer(u, ctx_ckv, ctx_krope, cos, sin, w_in, g_q, w_uq, g_kv, w_ukv, w_pool, pool_scale, w_out):
    c_q, c_kv, k_rope, x_pool = _split_in_proj(u @ w_in)
    c_kv = _rms_norm(c_kv, g_kv)
    q_nope, q_rope = _mla_queries(c_q, g_q, w_uq)
    q_rope = _apply_rope(q_rope, cos[:, None, :], sin[:, None, :])
    k_rope = _apply_rope(k_rope, cos, sin)
    k_nope, v = _mla_keys_values(jnp.concatenate([c_kv, ctx_ckv], axis=1), w_ukv)
    k_rope_all = jnp.concatenate([k_rope, ctx_krope], axis=1)
    attn = _mla_attention(q_nope, q_rope, k_nope, k_rope_all, v)
    pool = _multiscale_pool(x_pool, w_pool, pool_scale)
    return jnp.concatenate([attn, pool], -1) @ w_out, None


def _trunk_layer(x, mods, mix_fn, w_gate, w_up, w_down, gamma, beta):
    sh1, sc1, g1, sh2, sc2, g2, sh3, sc3, g3 = mods
    x = _post_norm(x, 0.5 * g1 * _swiglu(_modulate(x, sh1, sc1), w_gate[0], w_up[0], w_down[0]), gamma[0], beta[0])
    mix, aux = mix_fn(_modulate(x, sh2, sc2))
    x = _post_norm(x, g2 * mix, gamma[1], beta[1])
    x = _post_norm(x, 0.5 * g3 * _swiglu(_modulate(x, sh3, sc3), w_gate[1], w_up[1], w_down[1]), gamma[2], beta[2])
    return x, aux


def setup_inputs(seed: int = 0) -> dict:
    key = jax.random.key(seed)
    ks = jax.random.split(key, 21)

    def nrm(k, shape, s):
        return s * jax.random.normal(k, shape, jnp.float32)

    d_q = N_HEADS * (QK_NOPE_DIM + QK_ROPE_DIM)
    d_kv = N_HEADS * (QK_NOPE_DIM + V_HEAD_DIM)
    return {
        "x_prompt": nrm(ks[0], (BATCH, SEQ, D_MODEL), 1.0),
        "x_sample": nrm(ks[1], (DEC_BATCH, DEC_SEQ, D_MODEL), 1.0),
        "cache_ckv": nrm(ks[2], (DEC_BATCH, DEPTH, PAST_LEN, KV_LORA_RANK), 1.0),
        "cache_krope": nrm(ks[3], (DEC_BATCH, DEPTH, PAST_LEN, QK_ROPE_DIM), 1.0),
        "c": nrm(ks[4], (DEC_BATCH, D_MODEL), 1.0),
        "c_ctx": nrm(ks[5], (D_MODEL,), 1.0),
        "w_ada": nrm(ks[6], (DEPTH, D_MODEL, N_MOD * D_MODEL), 0.5 * D_MODEL ** -0.5),
        "b_ada": nrm(ks[7], (DEPTH, N_MOD * D_MODEL), 0.02),
        "w_in": nrm(ks[8], (DEPTH, D_MODEL, IN_PROJ_DIM), D_MODEL ** -0.5),
        "g_q": 1.0 + nrm(ks[9], (DEPTH, Q_LORA_RANK), 0.05),
        "w_uq": nrm(ks[10], (DEPTH, Q_LORA_RANK, d_q), Q_LORA_RANK ** -0.5),
        "g_kv": 1.0 + nrm(ks[11], (DEPTH, KV_LORA_RANK), 0.05),
        "w_ukv": nrm(ks[12], (DEPTH, KV_LORA_RANK, d_kv), KV_LORA_RANK ** -0.5),
        "w_pool": nrm(ks[13], (DEPTH, N_POOL_GROUPS, POOL_GROUP_DIM, POOL_GROUP_DIM), POOL_GROUP_DIM ** -0.5),
        "pool_scale": 0.5 + nrm(ks[14], (DEPTH, POOL_WIDTH), 0.05),
        "w_out": nrm(ks[15], (DEPTH, D_MODEL, D_MODEL), DEEPNORM_BETA * D_MODEL ** -0.5),
        "w_ffn_gate": nrm(ks[16], (DEPTH, 2, D_MODEL, D_FF), D_MODEL ** -0.5),
        "w_ffn_up": nrm(ks[17], (DEPTH, 2, D_MODEL, D_FF), D_MODEL ** -0.5),
        "w_ffn_down": nrm(ks[18], (DEPTH, 2, D_FF, D_MODEL), DEEPNORM_BETA * D_FF ** -0.5),
        "ln_gamma": 1.0 + nrm(ks[19], (DEPTH, 3, D_MODEL), 0.05),
        "ln_beta": nrm(ks[20], (DEPTH, 3, D_MODEL), 0.02),
    }


def reference(x_prompt, x_sample, cache_ckv, cache_krope, c, c_ctx, w_ada, b_ada, w_in, g_q, w_uq,
              g_kv, w_ukv, w_pool, pool_scale, w_out, w_ffn_gate, w_ffn_up, w_ffn_down, ln_gamma, ln_beta):
    cos, sin = _axial_rope(x_sample.shape[1])
    y_prompt = x_prompt
    y_sample = x_sample
    ckv_list = []
    krope_list = []
    for l in range(DEPTH):
        mix_w = (w_in[l], g_q[l], w_uq[l], g_kv[l], w_ukv[l], w_pool[l], pool_scale[l], w_out[l])
        mods_ctx = _modulation(c_ctx[None, :], w_ada[l], b_ada[l])
        y_prompt, (ckv_l, krope_l) = _trunk_layer(
            y_prompt, mods_ctx, lambda u: _context_mixer(u, *mix_w),
            w_ffn_gate[l], w_ffn_up[l], w_ffn_down[l], ln_gamma[l], ln_beta[l])
        ckv_list.append(ckv_l)
        krope_list.append(krope_l)
        mods_lat = _modulation(c, w_ada[l], b_ada[l])
        ctx_ckv = cache_ckv[:, l]
        ctx_krope = cache_krope[:, l]
        y_sample, _ = _trunk_layer(
            y_sample, mods_lat, lambda u: _latent_mixer(u, ctx_ckv, ctx_krope, cos, sin, *mix_w),
            w_ffn_gate[l], w_ffn_up[l], w_ffn_down[l], ln_gamma[l], ln_beta[l])
    state_ckv = jnp.stack(ckv_list, axis=1)
    state_krope = jnp.stack(krope_list, axis=1)
    return (y_prompt, y_sample, state_ckv, state_krope)
```

```cpp
#include <hip/hip_runtime.h>
#include <cstdio>
#include <cstdint>

#ifndef MK_ONE_LAUNCH
#define MK_ONE_LAUNCH 1
#endif

namespace pg8 {
#define PG8_LAS __attribute__((address_space(3)))
typedef unsigned short bf16_t;
typedef short bf16x8 __attribute__((ext_vector_type(8)));
typedef float f32x4 __attribute__((ext_vector_type(4)));
typedef unsigned u32x4 __attribute__((ext_vector_type(4)));
constexpr int BM = 256, BK = 64, HALF = 128, HTB = HALF * BK * 2  , STAGE_BYTES = 8 * HTB, NXCD = 8, WGM = 8;

__host__ __device__ __forceinline__ int lds_byte(int r, int c) { const int st = (r >> 4) * 2 + (c >> 5), rr = r & 15, cc = c & 31, ob = rr * 64 + cc * 2; return st * 1024 + (ob ^ (((ob >> 9) & 1) << 5)); }
__host__ __device__ __forceinline__ void stage_rc(int b, int& R, int& C) { const int st = b / 1024, sb = b % 1024, swz = sb ^ (((sb >> 9) & 1) << 5); R = (st >> 1) * 16 + swz / 64; C = (st & 1) * 32 + (swz % 64) / 2; }
__host__ __device__ __forceinline__ int perm32(int rho) { const int n = rho >> 4, i = rho & 15; return 8 * (i >> 2) + 4 * n + (i & 3); }

struct Unit { int pm, pn, k0, nk, kh; };
struct Gemm { const bf16_t* A; const bf16_t* Bt; int M, N, K, lda, ag_shift, ag_stride; };

struct StaticOrder {
    int nM, nN, nwg, G, c, nk;
    __host__ __device__ void init(int M, int N, int G_, int c_, int nk_) { nM = M / BM; nN = N / BM; nwg = nM * nN; G = G_; c = c_; nk = nk_; }
    __host__ __device__ __forceinline__ void map(int L, int& pm, int& pn) const {
        int wgid = L; { const int q = nwg / NXCD, r = nwg % NXCD, xcd = wgid % NXCD, off = wgid / NXCD; wgid = (xcd < r ? xcd * (q + 1) : r * (q + 1) + (xcd - r) * q) + off; }
        const int nig = WGM * nN, gid = wgid / nig, fm = gid * WGM, gsz = (nM - fm) < WGM ? (nM - fm) : WGM;
        pm = fm + ((wgid % nig) % gsz); pn = (wgid % nig) / gsz;
    }
    __host__ __device__ __forceinline__ bool next(int i, Unit& u) const { const long L = (long)i * G + c; if (L >= nwg) return false; int pm, pn; map((int)L, pm, pn); u.pm = pm; u.pn = pn; u.k0 = 0; u.nk = nk; u.kh = 0; return true; }
    __device__ __forceinline__ void a_ready(const Unit&) const {}
    __device__ __forceinline__ void done(const Unit&) const {}
};
struct SplitTailOrder {
    StaticOrder so; int ntail, nN, mfull, nk0, nk1;
    __host__ __device__ void init(int M, int Mfull, int N, int G_, int c_, int nk_, int nk0_) { so.init(Mfull, N, G_, c_, nk_); nN = N / BM; mfull = Mfull / BM; ntail = 2 * (M / BM - mfull) * nN; nk0 = nk0_; nk1 = nk_ - nk0_; }
    __host__ __device__ __forceinline__ bool next(int i, Unit& u) const {
        const long L0 = (long)i * so.G + so.c; if (L0 >= (long)so.nwg + ntail) return false;
        const bool full = L0 < so.nwg; const int Lf = full ? (int)L0 : 0, l = full ? 0 : (int)(L0 - so.nwg);
        int pmf, pnf; so.map(Lf, pmf, pnf);
        const int r = l / nN, kh = full ? 0 : (r & 1);
        u.pm = full ? pmf : mfull + (r >> 1); u.pn = full ? pnf : l % nN; u.kh = kh; u.k0 = kh ? nk0 : 0; u.nk = full ? so.nk : (kh ? nk1 : nk0); return true;
    }
    __device__ __forceinline__ void a_ready(const Unit&) const {}
    __device__ __forceinline__ void done(const Unit&) const {}
};

struct SplitAllOrder {
    int nN, ntot, n0, cr, nkh;
    __host__ __device__ void init(int M, int N, int cr_, int n0_, int nkh_) { nN = N / BM; ntot = 2 * (M / BM) * nN; n0 = n0_; cr = cr_; nkh = nkh_; }
    __host__ __device__ __forceinline__ bool next(int i, Unit& u) const {
        int l; if (i == 0) { if (cr >= n0) return false; l = cr; } else if (i == 1) { if (cr >= ntot - n0) return false; l = n0 + cr; } else return false;
        const int kh = l & 1, t = l >> 1; u.pn = t % nN; u.pm = t / nN; u.kh = kh; u.k0 = kh ? nkh : 0; u.nk = nkh; return true;
    }
    __device__ __forceinline__ void a_ready(const Unit&) const {}
    __device__ __forceinline__ void done(const Unit&) const {}
};

__device__ __forceinline__ unsigned cvt_pk_bf16(float lo, float hi) { unsigned r; asm volatile("v_cvt_pk_bf16_f32 %0, %1, %2" : "=v"(r) : "v"(lo), "v"(hi)); return r; }

constexpr int D_MODEL = 4096, N_MODS = 9 * D_MODEL;
constexpr int PM_SAMPLE0 = 32;
__device__ __forceinline__ int mset_of_pm(int pm) { return pm < PM_SAMPLE0 ? 0 : 1 + ((pm - PM_SAMPLE0) >> 2); }

__device__ __forceinline__ float silu_f(float g) { return g * __builtin_amdgcn_rcpf(1.0f + __builtin_amdgcn_exp2f(g * -1.4426950408889634f)); }

typedef unsigned u32x2 __attribute__((ext_vector_type(2)));
typedef short v2s16 __attribute__((ext_vector_type(2)));
__device__ __forceinline__ unsigned pk4_fp8_sc(float a, float b, float c, float d, float dscale) { v2s16 w = {0, 0}; w = __builtin_amdgcn_cvt_scalef32_pk_fp8_f32(w, a, b, dscale, false); w = __builtin_amdgcn_cvt_scalef32_pk_fp8_f32(w, c, d, dscale, true); return __builtin_bit_cast(unsigned, w); }
__device__ __forceinline__ unsigned pk4_fp8(float a, float b, float c, float d) { int w = 0; w = __builtin_amdgcn_cvt_pk_fp8_f32(a, b, w, false); w = __builtin_amdgcn_cvt_pk_fp8_f32(c, d, w, true); return (unsigned)w; }
struct EpiSwigluF8 {
    static constexpr bool PERM = true, AFTER_DRAIN = false;
    unsigned char* O; int ldc; float ws;
    __device__ __forceinline__ void operator()(const f32x4 (&acc)[2][2][4][2], const Unit& u, int wr, int wc, int fr, int fq) const {
        int lrow = wr * 64 + fr; asm volatile("" : "+v"(lrow));
        const int row0 = u.pm * BM + lrow, col0 = u.pn * HALF + wc * 32 + 8 * fq;
        const float c1 = -1.4426950408889634f * ws, dsc = 1.0f / (ws * ws);
#pragma unroll
        for (int ai = 0; ai < 2; ++ai)
#pragma unroll
            for (int m = 0; m < 4; ++m) { unsigned char* rowp = O + (size_t)(row0 + ai * HALF + m * 16) * ldc + col0;
                const f32x4 ag0 = acc[ai][0][m][0], ag1 = acc[ai][0][m][1], au0 = acc[ai][1][m][0], au1 = acc[ai][1][m][1];
                const f32x4 x0 = ag0 * c1, x1 = ag1 * c1; f32x4 r0, r1;
#pragma unroll
                for (int j = 0; j < 4; ++j) { r0[j] = __builtin_amdgcn_exp2f(x0[j]); r1[j] = __builtin_amdgcn_exp2f(x1[j]); }
                r0 = r0 + 1.0f; r1 = r1 + 1.0f;
#pragma unroll
                for (int j = 0; j < 4; ++j) { r0[j] = __builtin_amdgcn_rcpf(r0[j]); r1[j] = __builtin_amdgcn_rcpf(r1[j]); }
                const f32x4 h0 = (ag0 * au0) * r0, h1 = (ag1 * au1) * r1;
                u32x2 w; w.x = pk4_fp8_sc(h0[0], h0[1], h0[2], h0[3], dsc); w.y = pk4_fp8_sc(h1[0], h1[1], h1[2], h1[3], dsc);
                *(u32x2*)rowp = w; }
    }
};
struct EpiDelta {
    static constexpr bool PERM = true, AFTER_DRAIN = false;
    const float* gate; float gsc; bf16_t* out; bf16_t* out2;
    __device__ __forceinline__ void operator()(const f32x4 (&acc)[2][2][4][2], const Unit& u, int wr, int wc, int fr, int fq) const {
        bf16_t* const o1_ = out; bf16_t* const o2_ = out2; const float gs_ = gsc;
        const float* gp = gate + (size_t)mset_of_pm(u.pm) * N_MODS;
        int rl0 = wr * 64 + fr; asm volatile("" : "+v"(rl0));
        const int col0 = u.pn * BM + wc * 32 + 8 * fq;
        f32x4 gv[2][2];
#pragma unroll
        for (int bj = 0; bj < 2; ++bj)
#pragma unroll
            for (int n = 0; n < 2; ++n) gv[bj][n] = *(const f32x4*)(gp + col0 + bj * HALF + 4 * n) * gs_;
        bf16_t* base = u.kh ? o2_ + (size_t)((u.pm - PM_SAMPLE0) * BM + rl0) * D_MODEL + col0 : o1_ + (size_t)(u.pm * BM + rl0) * D_MODEL + col0;
#pragma unroll
        for (int ai = 0; ai < 2; ++ai)
#pragma unroll
            for (int m = 0; m < 4; ++m) { bf16_t* rowp = base + (size_t)(ai * HALF + m * 16) * D_MODEL;
#pragma unroll
                for (int bj = 0; bj < 2; ++bj) { const f32x4 v0 = acc[ai][bj][m][0] * gv[bj][0], v1 = acc[ai][bj][m][1] * gv[bj][1];
                    u32x4 w; w.x = cvt_pk_bf16(v0[0], v0[1]); w.y = cvt_pk_bf16(v0[2], v0[3]); w.z = cvt_pk_bf16(v1[0], v1[1]); w.w = cvt_pk_bf16(v1[2], v1[3]);
                    *(u32x4*)(rowp + bj * HALF) = w; } }
    }
};
struct EpiF32 {
    static constexpr bool PERM = false, AFTER_DRAIN = false;
    float* C; int ldc;
    __device__ __forceinline__ void operator()(const f32x4 (&acc)[2][2][4][2], const Unit& u, int wr, int wc, int fr, int fq) const {
        const int row0 = u.pm * BM + wr * 64 + fr, col0 = u.pn * BM + wc * 32 + 4 * fq;
#pragma unroll
        for (int ai = 0; ai < 2; ++ai)
#pragma unroll
            for (int m = 0; m < 4; ++m) { float* rowp = C + (size_t)(row0 + ai * HALF + m * 16) * ldc + col0;
#pragma unroll
                for (int bj = 0; bj < 2; ++bj)
#pragma unroll
                    for (int n = 0; n < 2; ++n) *(f32x4*)(rowp + bj * HALF + n * 16) = acc[ai][bj][m][n]; }
    }
};
struct EpiF32Map {
    static constexpr bool PERM = false, AFTER_DRAIN = false;
    float* C; int ldc; float s;
    __device__ __forceinline__ void operator()(const f32x4 (&acc)[2][2][4][2], const Unit& u, int wr, int wc, int fr, int fq) const {
        int lrow = wr * 64 + fr; asm volatile("" : "+v"(lrow));
        const int row0 = u.pm * BM + lrow, col0 = (u.pn < 4 ? u.pn * BM : 1600 + (u.pn - 4) * BM) + wc * 32 + 4 * fq; const float s_ = s;
#pragma unroll
        for (int ai = 0; ai < 2; ++ai)
#pragma unroll
            for (int m = 0; m < 4; ++m) { float* rowp = C + (size_t)(row0 + ai * HALF + m * 16) * ldc + col0;
#pragma unroll
                for (int bj = 0; bj < 2; ++bj)
#pragma unroll
                    for (int n = 0; n < 2; ++n) *(f32x4*)(rowp + bj * HALF + n * 16) = acc[ai][bj][m][n] * s_; }
    }
};
struct EpiF32Part {
    static constexpr bool PERM = false, AFTER_DRAIN = false;
    float* C0; int ld0, off0; float* C1; int ld1, ncols;
    __device__ __forceinline__ void operator()(const f32x4 (&acc)[2][2][4][2], const Unit& u, int wr, int wc, int fr, int fq) const {
        float* const c0_ = C0; float* const c1_ = C1; const int l0_ = ld0, l1_ = ld1, o0_ = off0, nc_ = ncols;
        int lrow = wr * 64 + fr; asm volatile("" : "+v"(lrow));
        const int row0 = u.pm * BM + lrow, colw = u.pn * BM + wc * 32;
        float* base = u.kh ? c1_ + (size_t)row0 * l1_ + colw + 4 * fq : c0_ + (size_t)row0 * l0_ + o0_ + colw + 4 * fq; const size_t ld = u.kh ? (size_t)l1_ : (size_t)l0_;
#pragma unroll
        for (int bj = 0; bj < 2; ++bj) { if (colw + bj * HALF >= nc_) continue;
#pragma unroll
            for (int ai = 0; ai < 2; ++ai)
#pragma unroll
                for (int m = 0; m < 4; ++m) { float* rowp = base + (size_t)(ai * HALF + m * 16) * ld + bj * HALF;
#pragma unroll
                    for (int n = 0; n < 2; ++n) *(f32x4*)(rowp + n * 16) = acc[ai][bj][m][n]; } }
    }
};
struct EpiBf16S {
    static constexpr bool PERM = true, AFTER_DRAIN = false;
    bf16_t* O; int ldc, col_off; const float* cscale; float s;
    __device__ __forceinline__ void operator()(const f32x4 (&acc)[2][2][4][2], const Unit& u, int wr, int wc, int fr, int fq) const {
        const int row0 = u.pm * BM + wr * 64 + fr, col0 = u.pn * BM + wc * 32 + 8 * fq;
        f32x4 sv[2][2];
#pragma unroll
        for (int bj = 0; bj < 2; ++bj)
#pragma unroll
            for (int n = 0; n < 2; ++n) sv[bj][n] = (cscale ? *(const f32x4*)(cscale + col0 + bj * HALF + 4 * n) : (f32x4){1.f, 1.f, 1.f, 1.f}) * s;
#pragma unroll
        for (int ai = 0; ai < 2; ++ai)
#pragma unroll
            for (int m = 0; m < 4; ++m) { bf16_t* rowp = O + (size_t)(row0 + ai * HALF + m * 16) * ldc + col_off + col0;
#pragma unroll
                for (int bj = 0; bj < 2; ++bj) { const f32x4 v0 = acc[ai][bj][m][0] * sv[bj][0], v1 = acc[ai][bj][m][1] * sv[bj][1];
                    u32x4 w; w.x = cvt_pk_bf16(v0[0], v0[1]); w.y = cvt_pk_bf16(v0[2], v0[3]); w.z = cvt_pk_bf16(v1[0], v1[1]); w.w = cvt_pk_bf16(v1[2], v1[3]);
                    *(u32x4*)(rowp + bj * HALF) = w; } }
    }
};

struct EpiF8S {
    static constexpr bool PERM = true, AFTER_DRAIN = false;
    unsigned char* O; int ldc, col_off; const float* cscale; float s;
    __device__ __forceinline__ void operator()(const f32x4 (&acc)[2][2][4][2], const Unit& u, int wr, int wc, int fr, int fq) const {
        int lrow = wr * 64 + fr; asm volatile("" : "+v"(lrow));
        const int row0 = u.pm * BM + lrow, col0 = u.pn * BM + wc * 32 + 8 * fq;
        f32x4 sv[2][2];
#pragma unroll
        for (int bj = 0; bj < 2; ++bj)
#pragma unroll
            for (int n = 0; n < 2; ++n) sv[bj][n] = *(const f32x4*)(cscale + col0 + bj * HALF + 4 * n) * s;
#pragma unroll
        for (int ai = 0; ai < 2; ++ai)
#pragma unroll
            for (int m = 0; m < 4; ++m) { unsigned char* rowp = O + (size_t)(row0 + ai * HALF + m * 16) * ldc + col_off + col0;
#pragma unroll
                for (int bj = 0; bj < 2; ++bj) { const f32x4 v0 = acc[ai][bj][m][0] * sv[bj][0], v1 = acc[ai][bj][m][1] * sv[bj][1];
                    u32x2 w; w.x = pk4_fp8(v0[0], v0[1], v0[2], v0[3]); w.y = pk4_fp8(v1[0], v1[1], v1[2], v1[3]);
                    *(u32x2*)(rowp + bj * HALF) = w; } }
    }
};

typedef int v8i32 __attribute__((ext_vector_type(8)));
typedef int v4i32 __attribute__((ext_vector_type(4)));
struct Frag2 { bf16x8 k[2]; };
template <bool F8> struct FragT { typedef Frag2 T; };
template <> struct FragT<true> { typedef v8i32 T; };
template <class Epi, class Sched, bool ALIGN_EPI = false, bool F8 = false>
__device__ __forceinline__ void gemm_phase(PG8_LAS unsigned char* lds, const Gemm g, const Sched& S, const Epi& E) {
    const int tid = threadIdx.x, wid = __builtin_amdgcn_readfirstlane(tid >> 6), lane = tid & 63, wr = wid >> 2, wc = wid & 3, fr = lane & 15, fq = lane >> 4;
    const int K = g.K, lda = g.lda; constexpr int EB = F8 ? 1 : 2;
    unsigned voffA[2], voffB[2];
#pragma unroll
    for (int i = 0; i < 2; ++i) { int R, C; stage_rc(tid * 16 + i * 8192, R, C); const int Rb = Epi::PERM ? ((R & ~31) + perm32(R & 31)) : R;
        voffA[i] = (unsigned)(R * lda) * (unsigned)EB + (unsigned)C * 2u; voffB[i] = (unsigned)(Rb * K) * (unsigned)EB + (unsigned)C * 2u; }
    const size_t kstep = (size_t)(BK * 2);
    const size_t hstepA = (size_t)HALF * lda * EB, hstepB = (size_t)HALF * K * EB;
    const size_t tstepA = 2 * hstepA, tstepB = 2 * hstepB;
    const unsigned ldsw = (unsigned)wid * 1024u;
    const int aoff = lds_byte(wr * 64 + fr, fq * 8); int boff = lds_byte(wc * 32 + fr, fq * 8) + 4 * HTB;
    asm volatile("" : "+v"(boff));
#define PG8_SA(b, h) (((b) * 2 + (h)) * HTB)
#define PG8_SB(b, h) ((4 + (b) * 2 + (h)) * HTB)
#define PG8_SBR(b, h) (((b) * 2 + (h)) * HTB)
#define PG8_STAGE(bufoff, gbase, voff) do { _Pragma("unroll") for (int _i = 0; _i < 2; ++_i) \
        __builtin_amdgcn_global_load_lds((const unsigned*)((const char*)(gbase) + (voff)[_i]), (PG8_LAS unsigned*)(lds + (bufoff) + ldsw + _i * 8192), 16, 0, 0); } while (0)
#define PG8_RD(off) (*(const PG8_LAS bf16x8*)(lds + (off)))
#define PG8_LDA(dst, b, h) do { _Pragma("unroll") for (int m = 0; m < 4; ++m) { if constexpr (F8) dst[m] = PG8_CAT(PG8_RD(PG8_SA(b, h) + aoff + m * 2048), PG8_RD(PG8_SA(b, h) + aoff + m * 2048 + 1024)); \
        else { dst[m].k[0] = PG8_RD(PG8_SA(b, h) + aoff + m * 2048); dst[m].k[1] = PG8_RD(PG8_SA(b, h) + aoff + m * 2048 + 1024); } } } while (0)
#define PG8_LDB(dst, b, h) do { _Pragma("unroll") for (int n = 0; n < 2; ++n) { if constexpr (F8) dst[n] = PG8_CAT(PG8_RD(PG8_SBR(b, h) + boff + n * 2048), PG8_RD(PG8_SBR(b, h) + boff + n * 2048 + 1024)); \
        else { dst[n].k[0] = PG8_RD(PG8_SBR(b, h) + boff + n * 2048); dst[n].k[1] = PG8_RD(PG8_SBR(b, h) + boff + n * 2048 + 1024); } } } while (0)
#define PG8_CAT(x, y) __builtin_shufflevector(__builtin_bit_cast(v4i32, x), __builtin_bit_cast(v4i32, y), 0, 1, 2, 3, 4, 5, 6, 7)
#define PG8_MMA(ai, bj, At, Bt) do { __builtin_amdgcn_s_setprio(1); _Pragma("unroll") for (int m = 0; m < 4; ++m) _Pragma("unroll") for (int n = 0; n < 2; ++n) { \
        if constexpr (F8) asm volatile("v_mfma_scale_f32_16x16x128_f8f6f4 %0, %1, %2, %0, %3, %3 op_sel_hi:[0,0,0]" : "+v"(acc[ai][bj][m][n]) : "v"(Bt[n]), "v"(At[m]), "v"(f8scl)); \
        else { _Pragma("unroll") for (int k = 0; k < 2; ++k) acc[ai][bj][m][n] = __builtin_amdgcn_mfma_f32_16x16x32_bf16(Bt[n].k[k], At[m].k[k], acc[ai][bj][m][n], 0, 0, 0); } } \
        __builtin_amdgcn_s_setprio(0); } while (0)
#define PG8_MMAZ(ai, bj, At, Bt) do { __builtin_amdgcn_s_setprio(1); _Pragma("unroll") for (int m = 0; m < 4; ++m) _Pragma("unroll") for (int n = 0; n < 2; ++n) { \
        asm volatile("v_mfma_scale_f32_16x16x128_f8f6f4 %0, %1, %2, 0, %3, %3 op_sel_hi:[0,0,0]" : "+v"(acc[ai][bj][m][n]) : "v"(Bt[n]), "v"(At[m]), "v"(f8scl)); } \
        __builtin_amdgcn_s_setprio(0); } while (0)
#define PG8_MMA0(z, ai, bj, At, Bt) do { if constexpr (F8) { if (z) PG8_MMAZ(ai, bj, At, Bt); else PG8_MMA(ai, bj, At, Bt); } else PG8_MMA(ai, bj, At, Bt); } while (0)
#define PG8_WAIT_V(n) asm volatile("s_waitcnt vmcnt(" #n ")" ::: "memory")
#define PG8_WAIT_L(n) asm volatile("s_waitcnt lgkmcnt(" #n ")" ::: "memory")
#define PG8_BAR __builtin_amdgcn_s_barrier()
#define PG8_SCHED __builtin_amdgcn_sched_barrier(0)
#define PG8_AOFF(u_) ((size_t)(u_).pm * tstepA + (size_t)((u_).pn >> g.ag_shift) * (size_t)g.ag_stride * EB + (size_t)(u_).k0 * kstep)
#define PG8_BOFF(u_) ((size_t)(u_).pn * tstepB + (size_t)(u_).k0 * kstep)
    Unit cur, nxt; int ui = 0;
    if (!S.next(0, cur)) return;
    const int f8scl = 0x7F7F7F7F;
    f32x4 acc[2][2][4][2];
    if constexpr (!F8) {
#pragma unroll
    for (int a = 0; a < 2; ++a)
#pragma unroll
        for (int b = 0; b < 2; ++b)
#pragma unroll
            for (int m = 0; m < 4; ++m)
#pragma unroll
                for (int n = 0; n < 2; ++n) acc[a][b][m][n] = (f32x4){0.f, 0.f, 0.f, 0.f};
    }
    typedef typename FragT<F8>::T frag_t;
    frag_t At[4], B0[2], B1[2];
    const char* cA = (const char*)g.A + PG8_AOFF(cur); const char* cB = (const char*)g.Bt + PG8_BOFF(cur);
    S.a_ready(cur);
    PG8_STAGE(PG8_SB(0, 0), cB, voffB); PG8_STAGE(PG8_SB(0, 1), cB + hstepB, voffB); PG8_STAGE(PG8_SA(0, 0), cA, voffA); PG8_STAGE(PG8_SA(0, 1), cA + hstepA, voffA);
    if (wr == 1) PG8_BAR;
    PG8_WAIT_V(2); PG8_BAR;
    PG8_STAGE(PG8_SB(1, 0), cB + kstep, voffB); PG8_STAGE(PG8_SA(1, 0), cA + kstep, voffA); PG8_STAGE(PG8_SB(1, 1), cB + hstepB + kstep, voffB);
    PG8_WAIT_V(6); PG8_BAR;
    for (;;) {
        const bool has_next = S.next(ui + 1, nxt);
        const char* nA = has_next ? (const char*)g.A + PG8_AOFF(nxt) : cA; const char* nB = has_next ? (const char*)g.Bt + PG8_BOFF(nxt) : cB;
        const int nt = cur.nk;
        for (int t = 0; t < nt; t += 2) {
            const bool last = (t == nt - 2);
            const char* a1 = cA + (size_t)(t + 1) * kstep;
            const char* a2 = last ? nA : cA + (size_t)(t + 2) * kstep; const char* b2 = last ? nB : cB + (size_t)(t + 2) * kstep;
            const char* a3 = a2 + kstep; const char* b3 = b2 + kstep;
            if (last && has_next) S.a_ready(nxt);
            PG8_LDB(B0, 0, 0); PG8_LDB(B1, 0, 1); PG8_SCHED; PG8_LDA(At, 0, 0); PG8_STAGE(PG8_SA(1, 1), a1 + hstepA, voffA);
            PG8_WAIT_V(8); PG8_WAIT_L(0); PG8_BAR; PG8_MMA0(t == 0, 0, 0, At, B0); PG8_MMA0(t == 0, 0, 1, At, B1); PG8_BAR; PG8_SCHED;
            PG8_LDA(At, 0, 1); PG8_STAGE(PG8_SB(0, 0), b2, voffB); PG8_STAGE(PG8_SB(0, 1), b2 + hstepB, voffB); PG8_STAGE(PG8_SA(0, 0), a2, voffA);
            PG8_WAIT_V(8); PG8_WAIT_L(0); PG8_BAR; PG8_MMA0(t == 0, 1, 0, At, B0); PG8_MMA0(t == 0, 1, 1, At, B1); PG8_BAR; PG8_SCHED;
            PG8_LDB(B0, 1, 0); PG8_LDB(B1, 1, 1); PG8_SCHED; PG8_LDA(At, 1, 0); PG8_STAGE(PG8_SA(0, 1), a2 + hstepA, voffA);
            PG8_WAIT_V(8); PG8_WAIT_L(0); PG8_BAR; PG8_MMA(0, 0, At, B0); PG8_MMA(0, 1, At, B1); PG8_BAR; PG8_SCHED;
            PG8_LDA(At, 1, 1); PG8_STAGE(PG8_SB(1, 0), b3, voffB); PG8_STAGE(PG8_SB(1, 1), b3 + hstepB, voffB); PG8_STAGE(PG8_SA(1, 0), a3, voffA);
            PG8_WAIT_V(8); PG8_WAIT_L(0); PG8_BAR; PG8_MMA(1, 0, At, B0); PG8_MMA(1, 1, At, B1); PG8_BAR; PG8_SCHED;
        }
        if constexpr (ALIGN_EPI) { if (wr == 0) PG8_BAR; }
        if constexpr (F8) asm volatile("s_nop 7\n\ts_nop 7\n\ts_nop 7" ::: "memory");
        E(acc, cur, wr, wc, fr, fq); S.done(cur);
        if (!has_next) break;
        if constexpr (!F8) {
#pragma unroll
        for (int a = 0; a < 2; ++a)
#pragma unroll
            for (int b = 0; b < 2; ++b)
#pragma unroll
                for (int m = 0; m < 4; ++m)
#pragma unroll
                    for (int n = 0; n < 2; ++n) acc[a][b][m][n] = (f32x4){0.f, 0.f, 0.f, 0.f};
        }
        cur = nxt; cA = nA; cB = nB; ++ui;
        if constexpr (ALIGN_EPI) { if (wr == 1) PG8_BAR; }
    }
    PG8_WAIT_V(0);
    if constexpr (!ALIGN_EPI) { if (wr == 0) PG8_BAR; }
    PG8_BAR;
#undef PG8_AOFF
#undef PG8_BOFF
#undef PG8_SA
#undef PG8_SB
#undef PG8_SBR
#undef PG8_STAGE
#undef PG8_LDA
#undef PG8_LDB
#undef PG8_MMA
#undef PG8_MMAZ
#undef PG8_MMA0
#undef PG8_CAT
#undef PG8_RD
#undef PG8_WAIT_V
#undef PG8_WAIT_L
#undef PG8_BAR
#undef PG8_SCHED
}
}

#define GAS __attribute__((address_space(1)))
#define LAS __attribute__((address_space(3)))
typedef unsigned short bf16;
typedef unsigned v4u __attribute__((ext_vector_type(4)));
typedef unsigned v2u __attribute__((ext_vector_type(2)));
typedef float f32x4 __attribute__((ext_vector_type(4)));
typedef short bf16x8 __attribute__((ext_vector_type(8)));
typedef GAS unsigned gu32;
#define RLX_AGENT __ATOMIC_RELAXED, __HIP_MEMORY_SCOPE_AGENT
#define LDS_WAIT() asm volatile("s_waitcnt lgkmcnt(0)" ::: "memory")
#define VM_WAIT() asm volatile("s_waitcnt vmcnt(0)" ::: "memory")
__device__ __forceinline__ unsigned f2bf(float f) { unsigned u = __builtin_bit_cast(unsigned, f); return (u + 0x7fffu + ((u >> 16) & 1u)) >> 16; }
__device__ __forceinline__ unsigned pk2(float lo, float hi) { return f2bf(lo) | (f2bf(hi) << 16); }

#define XB_TMO      128
#define XB_XCNT(j)  (256  + 64 * (j))
#define XB_XSUB(j)  (1280 + 64 * (j))
#define XB_XGEN(j)  (2304 + 64 * (j))
#define XB_TOP      3328
#define XB_TOPGEN   3392
#define XCD_BAR_WORDS 3456
#define XB_SPIN_CAP (1u << 18)

__device__ __forceinline__ unsigned xb_ld(unsigned* p)              { return __hip_atomic_load(p, __ATOMIC_RELAXED, __HIP_MEMORY_SCOPE_AGENT); }
__device__ __forceinline__ unsigned xb_add(unsigned* p, unsigned v) { return __hip_atomic_fetch_add(p, v, __ATOMIC_RELAXED, __HIP_MEMORY_SCOPE_AGENT); }
__device__ __forceinline__ unsigned xb_xcc_id() { return (unsigned)__builtin_amdgcn_s_getreg((3 << 11) | 20) & 0xFu; }
#define XB_SPIN(cond, bar) do { unsigned _sp = 0; while (cond) { __builtin_amdgcn_s_sleep(1); \
    if ((++_sp & 255u) == 0u) { if (xb_ld(&(bar)[XB_TMO])) break; if (_sp > XB_SPIN_CAP) { atomicAdd(&(bar)[XB_TMO], 1u); break; } } } } while (0)

struct XcdBarrier {
    unsigned* bar; unsigned x;
    volatile LAS unsigned* st;
};

__device__ __forceinline__ XcdBarrier xcd_barrier_post(unsigned* bar, volatile LAS unsigned* st) {
    XcdBarrier b; b.bar = bar; b.x = xb_xcc_id(); b.st = st;
    if (threadIdx.x == 0) (void)xb_add(&bar[XB_XCNT(b.x)], 1u);
    return b;
}
__device__ __forceinline__ void xcd_barrier_complete(unsigned* bar, unsigned x, unsigned& nloc, unsigned& nx) {
    const unsigned G = gridDim.x * gridDim.y * gridDim.z;
    unsigned sum, cnt, mine, sp = 0u;
    for (;;) {
        sum = 0u; cnt = 0u; mine = 0u;
#pragma unroll
        for (unsigned j = 0; j < 16; ++j) { const unsigned c = xb_ld(&bar[XB_XCNT(j)]); sum += c; cnt += (c > 0u) ? 1u : 0u; mine = (j == x) ? c : mine; }
        if (sum == G) break;
        __builtin_amdgcn_s_sleep(1);
        if ((++sp & 255u) == 0u) { if (xb_ld(&bar[XB_TMO])) break; if (sp > XB_SPIN_CAP) { atomicAdd(&bar[XB_TMO], 1u); break; } }
    }
    nloc = mine > 0u ? mine : 1u; nx = cnt > 0u ? cnt : 1u;
}

__device__ __forceinline__ void xcd_barrier(const XcdBarrier& b) {
    asm volatile("s_waitcnt vmcnt(0)" ::: "memory");
    __syncthreads();
    if (threadIdx.x == 0) {
        unsigned* bar = b.bar;
        __builtin_amdgcn_s_waitcnt(0);
        unsigned nloc = b.st[0], nx = b.st[1];
        if (nloc == 0u) { xcd_barrier_complete(bar, b.x, nloc, nx); b.st[0] = nloc; b.st[1] = nx; }
        __builtin_amdgcn_fence(__ATOMIC_RELEASE, "agent");
        asm volatile("s_waitcnt vmcnt(0)" ::: "memory");
        const unsigned old = xb_add(&bar[XB_XSUB(b.x)], 1u);
        const unsigned gen = old / nloc;
        if (old + 1u == (gen + 1u) * nloc) {
            __builtin_amdgcn_fence(__ATOMIC_RELEASE, "agent");
            asm volatile("s_waitcnt vmcnt(0)" ::: "memory");
            const unsigned og = xb_add(&bar[XB_TOP], 1u);
            const unsigned tg = og / nx;
            if (og + 1u == (tg + 1u) * nx) xb_add(&bar[XB_TOPGEN], 1u);
            else XB_SPIN(xb_ld(&bar[XB_TOPGEN]) == tg, bar);
            __builtin_amdgcn_fence(__ATOMIC_ACQUIRE, "agent");
            xb_add(&bar[XB_XGEN(b.x)], 1u);
            asm volatile("s_waitcnt vmcnt(0)" ::: "memory");
        } else {
            XB_SPIN(xb_ld(&bar[XB_XGEN(b.x)]) == gen, bar);
            __builtin_amdgcn_fence(__ATOMIC_ACQUIRE, "agent");
            asm volatile("s_waitcnt vmcnt(0)" ::: "memory");
        }
    }
    __syncthreads();
}

constexpr int DM = 4096, T_CTX = 8192, T_LAT = 2048, T = T_CTX + T_LAT, S_CTX = 256, S_LAT = 1024, PAST = 256, NB_CTX = 32, NB_LAT = 2;
constexpr int NCACHE = NB_LAT * PAST, TKV = T + NCACHE;
constexpr int NH = 16, DQK = 192, DNOPE = 128, DROPE = 64, DVH = 128, DQ = NH * DQK  , DKV = NH * (DNOPE + DVH)  ;
constexpr int QLORA = 1024, KVLORA = 512, POOLW = 2048, INP = 3648, INP_PAD = 3840, DFF = 11008, NGU = 2 * DFF;
constexpr int NMOD = 9 * DM;
constexpr float LN_EPS = 1e-5f, RMS_EPS = 1e-6f, DN_ALPHA = 1.189207115002721f;
constexpr float WGU_SCALE = 64.f, WD_SCALE = 128.f, WOUT_SCALE = 128.f, WIN_SCALE = 64.f, WUQ_SCALE = 32.f, WUKV_SCALE = 16.f, WPOOL_SCALE = 16.f, MIX_SCALE = 16.f;
constexpr size_t OUT_CKV = (size_t)T * DM, OUT_KROPE = OUT_CKV + (size_t)T_CTX * KVLORA, OUT_TOTAL = OUT_KROPE + (size_t)T_CTX * DROPE;
static_assert(pg8::D_MODEL == DM && pg8::N_MODS == NMOD, "shape constants");

constexpr size_t MiB = 1u << 20;
constexpr size_t WS_CTL = 0, CTL_ZERO_BYTES = 2 * MiB;
constexpr size_t WS_MODS = 1 * MiB;
constexpr size_t WS_ROPE = 2 * MiB;
constexpr size_t WS_WGU0 = 4 * MiB, WS_WGU1 = 176 * MiB;
constexpr size_t WS_WD0 = 348 * MiB, WS_WD1 = 434 * MiB;
constexpr size_t WS_WIN = 520 * MiB, WS_WUQ = 550 * MiB, WS_WUKV = 556 * MiB, WS_WPOOL = 560 * MiB, WS_WOUT = 562 * MiB;
constexpr size_t WS_U = 594 * MiB;
constexpr size_t WS_H = 674 * MiB;
constexpr size_t WS_PRE = 890 * MiB;
constexpr size_t WS_X1 = 1050 * MiB;
constexpr size_t WS_HP = 1210 * MiB;
constexpr size_t WS_CQN = 1360 * MiB, WS_CKV = 1380 * MiB, WS_KR = 1391 * MiB, WS_POOLED = 1393 * MiB, WS_Q = 1433 * MiB, WS_KV = 1493 * MiB, WS_MIXIN = 1577 * MiB;
constexpr size_t WS_END = 1657 * MiB;
static_assert(WS_WGU0 + (size_t)NGU * DM * 2 <= WS_WGU1 && WS_WGU1 + (size_t)NGU * DM * 2 <= WS_WD0 && WS_WD0 + (size_t)DM * DFF * 2 <= WS_WD1 && WS_WD1 + (size_t)DM * DFF * 2 <= WS_WIN, "ws map 1");
static_assert(WS_WIN + (size_t)INP_PAD * DM * 2 <= WS_WUQ && WS_WUQ + (size_t)DQ * QLORA * 2 <= WS_WUKV && WS_WUKV + (size_t)DKV * KVLORA * 2 <= WS_WPOOL && WS_WPOOL + (size_t)POOLW * 512 * 2 <= WS_WOUT && WS_WOUT + (size_t)DM * DM * 2 <= WS_U, "ws map 2");
static_assert(WS_U + (size_t)T * DM * 2 <= WS_H && WS_H + (size_t)T * DFF * 2 <= WS_PRE && WS_PRE + (size_t)T * DM * 4 <= WS_X1 && WS_X1 + (size_t)T * DM * 4 <= WS_HP && WS_HP + (size_t)T * INP_PAD * 4 <= WS_CQN, "ws map 3");
static_assert(WS_CQN + (size_t)T * QLORA * 2 <= WS_CKV && WS_CKV + (size_t)TKV * KVLORA * 2 <= WS_KR && WS_KR + (size_t)TKV * DROPE * 2 <= WS_POOLED && WS_POOLED + (size_t)T * POOLW * 2 <= WS_Q && WS_Q + (size_t)T * DQ * 2 <= WS_KV && WS_KV + (size_t)TKV * DKV * 2 <= WS_MIXIN && WS_MIXIN + (size_t)T * DM * 2 <= WS_END, "ws map 4");
static_assert(WS_MODS + (size_t)3 * NMOD * 4 <= CTL_ZERO_BYTES, "mods inside the memset region");
constexpr size_t WS_WIN8 = WS_WIN, WS_WINB = WS_WIN + 12 * MiB;
constexpr int NIN8 = QLORA + POOLW, NINB = 768, NINB_REAL = KVLORA + DROPE;
constexpr int CW_BAR = 4096;
constexpr int RING_OFF = 0, RING_BYTES = 131072;
constexpr int LDSCTL_OFF = RING_BYTES, MISC_OFF = LDSCTL_OFF + 320;
constexpr int LDS_BYTES = 147456;
constexpr int NWAVES = 8;

__device__ __forceinline__ float wave_sum(float v) {
#pragma unroll
    for (int o = 1; o < 64; o <<= 1) v += __shfl_xor(v, o);
    return v;
}
__device__ __forceinline__ float hsum4(f32x4 v) { return (v.x + v.y) + (v.z + v.w); }
__device__ __forceinline__ float hsq4(f32x4 v) { return (v.x * v.x + v.y * v.y) + (v.z * v.z + v.w * v.w); }
__device__ __forceinline__ void st_bf16x4(bf16* p, f32x4 v) { v2u w; w.x = pk2(v.x, v.y); w.y = pk2(v.z, v.w); *(GAS v2u*)p = w; }
__device__ __forceinline__ void st_fp8x4(unsigned char* p, f32x4 v) { *(GAS unsigned*)p = pg8::pk4_fp8(v.x, v.y, v.z, v.w); }

__device__ __forceinline__ void p0_ada(const float* c_ctx, const float* c, const float* w_ada, const float* b_ada, float* mods, LAS unsigned char* lds, int tid, int wave, int lane, int bid, int G) {
    LAS float* sc = (LAS float*)lds;
    LAS float* red = (LAS float*)(lds + 49152);
    for (int i = tid; i < 3 * DM; i += NWAVES * 64) { const int s = i >> 12, k = i & (DM - 1); const float v = (s == 0) ? c_ctx[k] : c[(s - 1) * DM + k]; sc[i] = v / (1.0f + __expf(-v)); }
    __syncthreads();
    constexpr int NKC = DM / 256, NCC = NMOD / 256;
    for (int it = bid; it < NKC * NCC; it += G) {
        const int kc = it / NCC, cc = it % NCC, k0 = kc * 256 + wave * 32;
        const float* wp = w_ada + (size_t)k0 * NMOD + cc * 256 + lane * 4;
        f32x4 a0 = {0.f, 0.f, 0.f, 0.f}, a1 = a0, a2 = a0;
#pragma unroll 16
        for (int i = 0; i < 32; ++i) { const f32x4 w = __builtin_nontemporal_load((const GAS f32x4*)(wp + (size_t)i * NMOD)); const float s0 = sc[k0 + i], s1 = sc[DM + k0 + i], s2 = sc[2 * DM + k0 + i]; a0 += w * s0; a1 += w * s1; a2 += w * s2; }
        *(LAS f32x4*)(red + (wave * 3 + 0) * 256 + lane * 4) = a0; *(LAS f32x4*)(red + (wave * 3 + 1) * 256 + lane * 4) = a1; *(LAS f32x4*)(red + (wave * 3 + 2) * 256 + lane * 4) = a2;
        __syncthreads();
        for (int o = tid; o < 768; o += NWAVES * 64) { const int s = o >> 8, col = o & 255; float sum = 0.f;
#pragma unroll
            for (int w = 0; w < NWAVES; ++w) sum += red[(w * 3 + s) * 256 + col];
            if (kc == 0) sum += b_ada[cc * 256 + col];
            atomicAdd(mods + (size_t)s * NMOD + cc * 256 + col, sum); }
        __syncthreads();
    }
}
__device__ __forceinline__ void tile_load32(float (&r_)[32], const float* W, int N, int k0, int n0, int lane) {
    const char* sb_ = (const char*)(W + (size_t)k0 * N + n0); const unsigned vb_ = (unsigned)((lane >> 5) * N + (lane & 31)) * 4u; const size_t st_ = (size_t)N * 8;
#pragma unroll
    for (int i = 0; i < 32; ++i) { const char* p_ = sb_ + (size_t)i * st_; asm volatile("global_load_dword %0, %1, %2 nt" : "=v"(r_[i]) : "v"(vb_), "s"(p_)); }
    asm volatile("s_waitcnt vmcnt(0)" : "+v"(r_[0]), "+v"(r_[1]), "+v"(r_[2]), "+v"(r_[3]), "+v"(r_[4]), "+v"(r_[5]), "+v"(r_[6]), "+v"(r_[7]) :: "memory");
    asm volatile("" : "+v"(r_[8]), "+v"(r_[9]), "+v"(r_[10]), "+v"(r_[11]), "+v"(r_[12]), "+v"(r_[13]), "+v"(r_[14]), "+v"(r_[15]));
    asm volatile("" : "+v"(r_[16]), "+v"(r_[17]), "+v"(r_[18]), "+v"(r_[19]), "+v"(r_[20]), "+v"(r_[21]), "+v"(r_[22]), "+v"(r_[23]));
    asm volatile("" : "+v"(r_[24]), "+v"(r_[25]), "+v"(r_[26]), "+v"(r_[27]), "+v"(r_[28]), "+v"(r_[29]), "+v"(r_[30]), "+v"(r_[31]));
}
__device__ __forceinline__ void transpose_item(const float* W, int N, int k0, int n0, bf16* WTrow0, int Kld, LAS float* scr, int lane) {
    { float r_[32]; tile_load32(r_, W, N, k0, n0, lane);
#pragma unroll
    for (int i = 0; i < 32; ++i) scr[(2 * i + (lane >> 5)) * 33 + (lane & 31)] = r_[i]; }
    LDS_WAIT(); asm volatile("" ::: "memory");
    const int c = lane & 7;
#pragma unroll
    for (int j = 0; j < 4; ++j) { const int n = (lane >> 3) + 8 * j; const LAS float* s = scr + (8 * c) * 33 + n;
        v4u o; o.x = pk2(s[0 * 33], s[1 * 33]); o.y = pk2(s[2 * 33], s[3 * 33]); o.z = pk2(s[4 * 33], s[5 * 33]); o.w = pk2(s[6 * 33], s[7 * 33]);
        *(GAS v4u*)(WTrow0 + (size_t)n * Kld + k0 + 8 * c) = o; }
    LDS_WAIT(); asm volatile("" ::: "memory");
}
__device__ __forceinline__ void transpose_item_f8(const float* W, int N, int k0, int n0, unsigned char* WTrow0, int Kld, float scale, LAS float* scr, int lane) {
    { float r_[32]; tile_load32(r_, W, N, k0, n0, lane);
#pragma unroll
    for (int i = 0; i < 32; ++i) scr[(2 * i + (lane >> 5)) * 33 + (lane & 31)] = r_[i]; }
    LDS_WAIT(); asm volatile("" ::: "memory");
    const int c = lane & 3;
    const float ds = 1.0f / scale;
#pragma unroll
    for (int j = 0; j < 2; ++j) { const int n = (lane >> 2) + 16 * j; const LAS float* s = scr + (16 * c) * 33 + n;
        v4u o; o.x = pg8::pk4_fp8_sc(s[0 * 33], s[1 * 33], s[2 * 33], s[3 * 33], ds); o.y = pg8::pk4_fp8_sc(s[4 * 33], s[5 * 33], s[6 * 33], s[7 * 33], ds);
        o.z = pg8::pk4_fp8_sc(s[8 * 33], s[9 * 33], s[10 * 33], s[11 * 33], ds); o.w = pg8::pk4_fp8_sc(s[12 * 33], s[13 * 33], s[14 * 33], s[15 * 33], ds);
        *(GAS v4u*)(WTrow0 + (size_t)n * Kld + k0 + 16 * c) = o; }
    LDS_WAIT(); asm volatile("" ::: "memory");
}
__device__ __forceinline__ void tile_fin_f8(const float (&r_)[32], int k0, unsigned char* WTrow0, int Kld, float ds, LAS float* scr, int lane) {
#pragma unroll
    for (int i = 0; i < 32; ++i) scr[(2 * i + (lane >> 5)) * 33 + (lane & 31)] = r_[i];
    LDS_WAIT(); asm volatile("" ::: "memory");
    const int c = lane & 3;
#pragma unroll
    for (int j = 0; j < 2; ++j) { const int n = (lane >> 2) + 16 * j; const LAS float* s = scr + (16 * c) * 33 + n;
        v4u o; o.x = pg8::pk4_fp8_sc(s[0 * 33], s[1 * 33], s[2 * 33], s[3 * 33], ds); o.y = pg8::pk4_fp8_sc(s[4 * 33], s[5 * 33], s[6 * 33], s[7 * 33], ds);
        o.z = pg8::pk4_fp8_sc(s[8 * 33], s[9 * 33], s[10 * 33], s[11 * 33], ds); o.w = pg8::pk4_fp8_sc(s[12 * 33], s[13 * 33], s[14 * 33], s[15 * 33], ds);
        *(GAS v4u*)(WTrow0 + (size_t)n * Kld + k0 + 16 * c) = o; }
    LDS_WAIT(); asm volatile("" ::: "memory");
}
__device__ __forceinline__ void transpose_item_f8_x2(const float* W, int N, int k0, int n0, unsigned char* WTrow0, int Kld, float scale, LAS float* scr, int lane) {
    float ra[32], rb[32];
    const char* sb_ = (const char*)(W + (size_t)k0 * N + n0); const unsigned vb_ = (unsigned)((lane >> 5) * N + (lane & 31)) * 4u; const size_t st_ = (size_t)N * 8;
#pragma unroll
    for (int i = 0; i < 32; ++i) { const char* p_ = sb_ + (size_t)i * st_; asm volatile("global_load_dword %0, %1, %2 nt" : "=v"(ra[i]) : "v"(vb_), "s"(p_)); asm volatile("global_load_dword %0, %1, %2 offset:128 nt" : "=v"(rb[i]) : "v"(vb_), "s"(p_)); }
    asm volatile("s_waitcnt vmcnt(0)" : "+v"(ra[0]), "+v"(ra[1]), "+v"(ra[2]), "+v"(ra[3]), "+v"(ra[4]), "+v"(ra[5]), "+v"(ra[6]), "+v"(ra[7]) :: "memory");
    asm volatile("" : "+v"(ra[8]), "+v"(ra[9]), "+v"(ra[10]), "+v"(ra[11]), "+v"(ra[12]), "+v"(ra[13]), "+v"(ra[14]), "+v"(ra[15]));
    asm volatile("" : "+v"(ra[16]), "+v"(ra[17]), "+v"(ra[18]), "+v"(ra[19]), "+v"(ra[20]), "+v"(ra[21]), "+v"(ra[22]), "+v"(ra[23]));
    asm volatile("" : "+v"(ra[24]), "+v"(ra[25]), "+v"(ra[26]), "+v"(ra[27]), "+v"(ra[28]), "+v"(ra[29]), "+v"(ra[30]), "+v"(ra[31]));
    asm volatile("" : "+v"(rb[0]), "+v"(rb[1]), "+v"(rb[2]), "+v"(rb[3]), "+v"(rb[4]), "+v"(rb[5]), "+v"(rb[6]), "+v"(rb[7]));
    asm volatile("" : "+v"(rb[8]), "+v"(rb[9]), "+v"(rb[10]), "+v"(rb[11]), "+v"(rb[12]), "+v"(rb[13]), "+v"(rb[14]), "+v"(rb[15]));
    asm volatile("" : "+v"(rb[16]), "+v"(rb[17]), "+v"(rb[18]), "+v"(rb[19]), "+v"(rb[20]), "+v"(rb[21]), "+v"(rb[22]), "+v"(rb[23]));
    asm volatile("" : "+v"(rb[24]), "+v"(rb[25]), "+v"(rb[26]), "+v"(rb[27]), "+v"(rb[28]), "+v"(rb[29]), "+v"(rb[30]), "+v"(rb[31]));
    const float ds = 1.0f / scale;
    tile_fin_f8(ra, k0, WTrow0, Kld, ds, scr, lane);
    tile_fin_f8(rb, k0, WTrow0 + (size_t)32 * Kld, Kld, ds, scr, lane);
}
__device__ const double ROPE_INVF[16] = {1.0, 0.5623413251903491, 0.31622776601683794, 0.17782794100389228, 0.1, 0.05623413251903491, 0.031622776601683794, 0.017782794100389228,
                                          0.01, 0.005623413251903491, 0.0031622776601683794, 0.0017782794100389228, 0.001, 0.0005623413251903491, 0.00031622776601683794, 0.00017782794100389228};
__device__ __forceinline__ void sincos_small(double x, double& s, double& c) {
    const double k = __builtin_rint(x * 0.6366197723675814);
    double r = __builtin_fma(-k, 1.5707963267948966, x); r = __builtin_fma(-k, 6.123233995736766e-17, r);
    const int q = ((int)k) & 3; const double r2 = r * r;
    const double sp = r * (1.0 + r2 * (-1.0 / 6 + r2 * (1.0 / 120 + r2 * (-1.0 / 5040 + r2 * (1.0 / 362880 + r2 * (-1.0 / 39916800 + r2 * (1.0 / 6227020800.0)))))));
    const double cp = 1.0 + r2 * (-0.5 + r2 * (1.0 / 24 + r2 * (-1.0 / 720 + r2 * (1.0 / 40320 + r2 * (-1.0 / 3628800 + r2 * (1.0 / 479001600.0 + r2 * (-1.0 / 87178291200.0)))))));
    s = (q == 0) ? sp : (q == 1) ? cp : (q == 2) ? -sp : -cp;
    c = (q == 0) ? cp : (q == 1) ? -sp : (q == 2) ? -cp : sp;
}
struct WPtrs { const float *w_in, *w_uq, *w_ukv, *w_pool, *w_out, *w_gate, *w_up, *w_down; };
__device__ __forceinline__ void p0_convert(const WPtrs& P, unsigned char* ws, LAS unsigned char* lds, int tid, int wave, int lane, int bid, int G) {
    LAS float* scr = (LAS float*)(lds + wave * 16384);
    const int gw = bid * NWAVES + wave, NGW = G * NWAVES;
    constexpr int I_GU = (DM / 64) * (DFF / 32), I_D = (DFF / 64) * (DM / 32), I_IN = (DM / 64) * (INP / 32), I_UQ = (QLORA / 64) * (DQ / 32), I_UKV = (KVLORA / 64) * (DKV / 32), I_P1 = (512 / 64) * (512 / 32), I_OUT = (DM / 64) * (DM / 32);
    constexpr int NITEMS = 4 * I_GU + I_IN + I_UQ + I_UKV + 4 * I_P1 + I_OUT;
    for (int it = gw; it < NITEMS; it += NGW) {
        int r = it;
        if (r < 4 * I_GU) { const int which = r / I_GU; r -= which * I_GU; const int l = which >> 1, up = which & 1; const float* W = (up ? P.w_up : P.w_gate) + (size_t)l * DM * DFF;
            constexpr int nb2 = DFF / 64; const int g8 = r >> 3, w8 = r & 7, kb = 4 * (g8 / nb2) + (w8 >> 1), n0 = (2 * (g8 % nb2) + (w8 & 1)) * 32;
            unsigned char* WT = (ws + (l ? WS_WGU1 : WS_WGU0))
                 + (size_t)((n0 >> 7) * 256 + (n0 & 127) + up * 128) * DM;
            transpose_item_f8(W, DFF, kb * 64, n0, WT, DM, WGU_SCALE, scr, lane); continue; }
        r -= 4 * I_GU;
        if (r < I_IN) { constexpr int nblk = INP / 32; const int kb = r / nblk, n0 = (r % nblk) * 32;
            if (n0 >= QLORA && n0 < QLORA + NINB_REAL) transpose_item(P.w_in, INP, kb * 64, n0, (bf16*)(ws + WS_WINB) + (size_t)(n0 - QLORA) * DM, DM, scr, lane);
            else transpose_item_f8(P.w_in, INP, kb * 64, n0, (ws + WS_WIN8) + (size_t)(n0 < QLORA ? n0 : n0 - NINB_REAL) * DM, DM, WIN_SCALE, scr, lane);
            continue; }
        r -= I_IN;
        if (r < I_UQ) { constexpr int nblk = DQ / 32; const int kb = r / nblk, n0 = (r % nblk) * 32; transpose_item_f8(P.w_uq, DQ, kb * 64, n0, (ws + WS_WUQ) + (size_t)n0 * QLORA, QLORA, WUQ_SCALE, scr, lane); continue; }
        r -= I_UQ;
        if (r < I_UKV) { constexpr int nblk = DKV / 32; const int kb = r / nblk, n0 = (r % nblk) * 32; transpose_item_f8(P.w_ukv, DKV, kb * 64, n0, (ws + WS_WUKV) + (size_t)n0 * KVLORA, KVLORA, WUKV_SCALE, scr, lane); continue; }
        r -= I_UKV;
        if (r < 4 * I_P1) { const int gi = r / I_P1; r -= gi * I_P1; constexpr int nblk = 512 / 32; const int kb = r / nblk, n0 = (r % nblk) * 32;
            transpose_item_f8(P.w_pool + (size_t)gi * 512 * 512, 512, kb * 64, n0, (ws + WS_WPOOL) + (size_t)(gi * 512 + n0) * 512, 512, WPOOL_SCALE, scr, lane); continue; }
        r -= 4 * I_P1;
        { constexpr int nblk = DM / 32; const int kb = r / nblk, n0 = (r % nblk) * 32; transpose_item_f8(P.w_out, DM, kb * 64, n0, (ws + WS_WOUT) + (size_t)n0 * DM, DM, WOUT_SCALE, scr, lane); }
    }
    { GAS v4u* z = (GAS v4u*)((bf16*)(ws + WS_WINB) + (size_t)NINB_REAL * DM); const int n16 = (NINB - NINB_REAL) * DM * 2 / 16;
        for (int i = bid * (NWAVES * 64) + tid; i < n16; i += G * NWAVES * 64) z[i] = (v4u){0u, 0u, 0u, 0u}; }
    { float* tab = (float*)(ws + WS_ROPE);
        for (int i = bid * (NWAVES * 64) + tid; i < S_LAT * 32; i += G * NWAVES * 64) { const int pos = i >> 5, f = i & 31; const double id = (f < 16) ? (double)(pos >> 6) : (double)(pos & 63);
            double s, c; sincos_small(id * ROPE_INVF[f & 15], s, c); tab[i] = (float)c; tab[S_LAT * 32 + i] = (float)s; } }
}

__device__ __forceinline__ void convert_wdown(const float* w_down_l, unsigned char* WD, LAS unsigned char* lds, int wave, int lane, int rank, int nidle) {
    LAS float* scr = (LAS float*)(lds + wave * 16384);
    constexpr int I_D = (DFF / 64) * (DM / 64), nb2 = DM / 128;
    for (int it = rank * NWAVES + wave; it < I_D; it += nidle * NWAVES) { const int g8 = it >> 3, w8 = it & 7, kb = 4 * (g8 / nb2) + (w8 >> 1), n0 = (2 * (g8 % nb2) + (w8 & 1)) * 64;
        transpose_item_f8_x2(w_down_l, DM, kb * 64, n0, WD + (size_t)n0 * DFF, DFF, WD_SCALE, scr, lane); }
}

__device__ __forceinline__ const float* x_row(const float* x_prompt, const float* x_sample, int m) { return m < T_CTX ? x_prompt + (size_t)m * DM : x_sample + (size_t)(m - T_CTX) * DM; }
__device__ __forceinline__ int mset_of_row(int m) { return m < T_CTX ? 0 : 1 + ((m - T_CTX) >> 10); }
__device__ __forceinline__ f32x4 bf4_to_f32(v2u w) { f32x4 r; r.x = __uint_as_float(w.x << 16); r.y = __uint_as_float(w.x & 0xffff0000u); r.z = __uint_as_float(w.y << 16); r.w = __uint_as_float(w.y & 0xffff0000u); return r; }
struct RowRegs { f32x4 r[16]; v2u d[16]; };
constexpr int LN_LDS_GAMMA = 0, LN_LDS_BETA = 16384, LN_LDS_MOD = 32768;
template <bool AFFINE> __device__ __forceinline__ void ln_load(RowRegs& R, const float* res, const bf16* d, int lane) {
    const GAS f32x4* xr = (const GAS f32x4*)res + lane;
#pragma unroll
    for (int j = 0; j < 16; ++j) R.r[j] = __builtin_nontemporal_load(&xr[64 * j]);
    if constexpr (AFFINE) { const GAS v2u* dr = (const GAS v2u*)d + lane;
#pragma unroll
        for (int j = 0; j < 16; ++j) R.d[j] = __builtin_nontemporal_load(&dr[64 * j]); }
    asm volatile("" ::: "memory");
}
template <bool AFFINE> __device__ __forceinline__ float ln_combine(f32x4 (&cur)[16], const RowRegs& R, const bf16* d2, int lane) {
    float s = 0.f;
    if constexpr (AFFINE) {
        if (d2) { const GAS v2u* d2r = (const GAS v2u*)d2 + lane;
#pragma unroll
            for (int j = 0; j < 16; ++j) { cur[j] = R.r[j] * DN_ALPHA + (bf4_to_f32(R.d[j]) + bf4_to_f32(d2r[64 * j])); s += hsum4(cur[j]); } }
        else {
#pragma unroll
            for (int j = 0; j < 16; ++j) { cur[j] = R.r[j] * DN_ALPHA + bf4_to_f32(R.d[j]); s += hsum4(cur[j]); } }
    } else {
#pragma unroll
        for (int j = 0; j < 16; ++j) { cur[j] = R.r[j]; s += hsum4(cur[j]); }
    }
    asm volatile("" ::: "memory");
    return s;
}
template <bool AFFINE, bool MOD, int OUTM  >
__device__ __forceinline__ void ln_finish(f32x4 (&v)[16], float s, LAS unsigned char* lds, int mset, float* xout, bf16* uout, unsigned char* uout8, int lane) {
    float mean = wave_sum(s) * (1.f / DM), s2 = 0.f;
#pragma unroll
    for (int j = 0; j < 16; ++j) { v[j] = v[j] - mean; s2 += hsq4(v[j]); }
    float rstd = 1.0f / sqrtf(wave_sum(s2) * (1.f / DM) + LN_EPS);
    if constexpr (AFFINE) {
        const LAS f32x4* g4 = (const LAS f32x4*)(lds + LN_LDS_GAMMA) + lane; const LAS f32x4* b4 = (const LAS f32x4*)(lds + LN_LDS_BETA) + lane; GAS f32x4* xo = (GAS f32x4*)xout + lane;
        s = 0.f;
#pragma unroll
        for (int j = 0; j < 16; ++j) { v[j] = v[j] * rstd * g4[64 * j] + b4[64 * j]; __builtin_nontemporal_store(v[j], &xo[64 * j]); s += hsum4(v[j]); if ((j & 3) == 3) asm volatile("" ::: "memory"); }
        if constexpr (MOD) {
            mean = wave_sum(s) * (1.f / DM); s2 = 0.f;
#pragma unroll
            for (int j = 0; j < 16; ++j) { v[j] = v[j] - mean; s2 += hsq4(v[j]); }
            rstd = 1.0f / sqrtf(wave_sum(s2) * (1.f / DM) + LN_EPS);
        }
    }
    if constexpr (MOD) {
        const LAS f32x4* sh4 = (const LAS f32x4*)(lds + LN_LDS_MOD + mset * 32768) + lane; const LAS f32x4* sc4 = (const LAS f32x4*)(lds + LN_LDS_MOD + mset * 32768 + 16384) + lane;
#pragma unroll
        for (int j = 0; j < 16; ++j) { const f32x4 o = v[j] * rstd * (sc4[64 * j] + 1.0f) + sh4[64 * j];
            if constexpr (OUTM >= 1) *((GAS unsigned*)uout8 + lane + 64 * j) = pg8::pk4_fp8(o.x, o.y, o.z, o.w);
            if constexpr (OUTM != 1) st_bf16x4(uout + 4 * (lane + 64 * j), o);
            if ((j & 3) == 3) asm volatile("" ::: "memory"); }
    }
}
template <bool AFFINE, bool MOD, int OUTM>
__device__ __forceinline__ void ln_phase(const float* resA, const float* resB, const bf16* d, const bf16* d2, const float* gamma, const float* beta, const float* mods, int ish, int isc,
                                         float* xoutA, float* xoutB, bf16* uout, unsigned char* uout8, LAS unsigned char* lds, int tid, int lane, int gw, int NGW) {
    for (int c = tid; c < 8192; c += NWAVES * 64) { const int reg = c >> 10, o = (c & 1023) * 4; const float* src;
        if (reg == 0) src = gamma; else if (reg == 1) src = beta; else { const int sset = (reg - 2) >> 1; src = mods + (size_t)sset * NMOD + (size_t)(((reg - 2) & 1) ? isc : ish) * DM; }
        if ((reg >= 2) ? MOD : AFFINE) *(LAS f32x4*)(lds + c * 16) = *(const GAS f32x4*)(src + o); }
    LDS_WAIT(); __syncthreads();
    RowRegs N; f32x4 cur[16];
    int m = gw;
    if (m < T) ln_load<AFFINE>(N, m < T_CTX ? resA + (size_t)m * DM : resB + (size_t)(m - T_CTX) * DM, d + (size_t)m * DM, lane);
    for (; m < T; m += NGW) {
        const float s = ln_combine<AFFINE>(cur, N, (AFFINE && m >= T_CTX) ? d2 + (size_t)(m - T_CTX) * DM : (const bf16*)nullptr, lane);
        const int mn = m + NGW;
        if (mn < T) ln_load<AFFINE>(N, mn < T_CTX ? resA + (size_t)mn * DM : resB + (size_t)(mn - T_CTX) * DM, d + (size_t)mn * DM, lane);
        ln_finish<AFFINE, MOD, OUTM>(cur, s, lds, mset_of_row(m), AFFINE ? (m < T_CTX ? xoutA + (size_t)m * DM : xoutB + (size_t)(m - T_CTX) * DM) : (float*)nullptr, uout + (size_t)m * DM, uout8 + (size_t)m * DM, lane);
    }
    __syncthreads();
}
__device__ __forceinline__ void p6_row(int m, const bf16* __restrict__ HQP, const float* __restrict__ HK0, const float* __restrict__ HK1, const float* __restrict__ g_q, const float* __restrict__ g_kv, const float* __restrict__ rope_tab,
                                       float* __restrict__ out, unsigned char* __restrict__ CQN, unsigned char* __restrict__ CKV, bf16* __restrict__ KR, unsigned char* __restrict__ POOLED, int lane) {
    const bf16* hq = HQP + (size_t)m * NIN8; const float* k0p = HK0 + (size_t)m * NINB; const float* k1p = HK1 + (size_t)m * NINB;
    int t, len; if (m < T_CTX) { t = m & (S_CTX - 1); len = S_CTX; } else { t = (m - T_CTX) & (S_LAT - 1); len = S_LAT; }
    const bf16* base = HQP + (size_t)(m - t) * NIN8 + QLORA;
    v2u cq[4]; f32x4 ka[2], kb[2];
#pragma unroll
    for (int j = 0; j < 4; ++j) cq[j] = *(const GAS v2u*)(hq + 4 * (lane + 64 * j));
#pragma unroll
    for (int j = 0; j < 2; ++j) { ka[j] = *(const GAS f32x4*)(k0p + 4 * (lane + 64 * j)); kb[j] = *(const GAS f32x4*)(k1p + 4 * (lane + 64 * j)); }
    float kr = k0p[KVLORA + lane] + k1p[KVLORA + lane];
    v4u w[30], xc[4];
    {   int q = 0;
#pragma unroll
        for (int gi = 0; gi < 4; ++gi) { const int half = 1 << gi;
#pragma unroll
            for (int dr = -half; dr < half; ++dr, ++q) { const int r = t + dr; const bool ok = (r >= 0) && (r < len); const int rc = ok ? r : t;
                w[q] = *(const GAS v4u*)(base + (size_t)rc * NIN8 + gi * 512 + 8 * lane); }
            xc[gi] = *(const GAS v4u*)(base + (size_t)t * NIN8 + gi * 512 + 8 * lane); } }
    {   f32x4 v[4]; float s = 0.f;
#pragma unroll
        for (int j = 0; j < 4; ++j) { v[j] = bf4_to_f32(cq[j]); s += hsq4(v[j]); }
        const float rstd = 1.0f / sqrtf(wave_sum(s) * (1.f / QLORA) + RMS_EPS);
#pragma unroll
        for (int j = 0; j < 4; ++j) { const f32x4 g = *(const GAS f32x4*)(g_q + 4 * (lane + 64 * j)); st_fp8x4(CQN + (size_t)m * QLORA + 4 * (lane + 64 * j), v[j] * rstd * g); } }
    {   f32x4 v[2]; float s = 0.f;
#pragma unroll
        for (int j = 0; j < 2; ++j) { v[j] = ka[j] + kb[j]; s += hsq4(v[j]); }
        const float rstd = 1.0f / sqrtf(wave_sum(s) * (1.f / KVLORA) + RMS_EPS);
#pragma unroll
        for (int j = 0; j < 2; ++j) { const f32x4 g = *(const GAS f32x4*)(g_kv + 4 * (lane + 64 * j)); const f32x4 o = v[j] * rstd * g;
            if (m < T_CTX) *(GAS f32x4*)(out + OUT_CKV + (size_t)m * KVLORA + 4 * (lane + 64 * j)) = o;
            st_fp8x4(CKV + (size_t)m * KVLORA + 4 * (lane + 64 * j), o); } }
    {   float v = kr;
        if (m < T_CTX) out[OUT_KROPE + (size_t)m * DROPE + lane] = v;
        else { const int pos = (m - T_CTX) & (S_LAT - 1), i = lane & 31; const float cs = rope_tab[pos * 32 + i], sn = rope_tab[S_LAT * 32 + pos * 32 + i]; const float other = __shfl_xor(v, 32);
            v = (lane < 32) ? v * cs - other * sn : other * sn + v * cs; }
        KR[(size_t)m * DROPE + lane] = (bf16)f2bf(v); }
    {   int q = 0;
#pragma unroll
        for (int gi = 0; gi < 4; ++gi) { const int half = 1 << gi; const int lo = (t - half) > 0 ? (t - half) : 0, hi = (t + half) < len ? (t + half) : len;
            f32x4 a0 = {0.f, 0.f, 0.f, 0.f}, a1 = a0;
#pragma unroll
            for (int dr = -half; dr < half; ++dr, ++q) { const int r = t + dr; const float wgt = ((r >= 0) && (r < len)) ? 1.0f : 0.0f;
                a0 += bf4_to_f32((v2u){w[q].x, w[q].y}) * wgt; a1 += bf4_to_f32((v2u){w[q].z, w[q].w}) * wgt; }
            const float inv = 1.0f / (float)(hi - lo);
            const f32x4 o0 = a0 * inv - bf4_to_f32((v2u){xc[gi].x, xc[gi].y}), o1 = a1 * inv - bf4_to_f32((v2u){xc[gi].z, xc[gi].w});
            v2u ow; ow.x = pg8::pk4_fp8(o0.x, o0.y, o0.z, o0.w); ow.y = pg8::pk4_fp8(o1.x, o1.y, o1.z, o1.w);
            *(GAS v2u*)(POOLED + (size_t)m * POOLW + gi * 512 + 8 * lane) = ow; } }
}

namespace att {
using f32x16 = __attribute__((ext_vector_type(16))) float;
using s16x4  = __attribute__((ext_vector_type(4))) short;
using u32x4  = __attribute__((ext_vector_type(4))) unsigned;
typedef short v4i16_t __attribute__((ext_vector_type(4)));
typedef LAS const char* lds_cptr;
constexpr float SCALE = 0.07216878364870322f;
constexpr float THR = 8.f;
constexpr int SHM_V = 64 * 128 * 2, SHM_KN = 64 * 128 * 2, SHM_KR = 64 * 64 * 2;
constexpr int OFF_V = 0, OFF_KN = 2 * SHM_V, OFF_KR = OFF_KN + 2 * SHM_KN, OFF_WS = OFF_KR + 2 * SHM_KR, ATT_LDS_BYTES = OFF_WS + NWAVES * 64 * 4;
static_assert(ATT_LDS_BYTES <= RING_BYTES, "attention LDS");
#define KSWZ(row, colB) ((row) * 256 + ((colB) ^ (((row) & 7) << 4)))
#define RSWZ(row, colB) ((row) * 128 + ((colB) ^ (((row) & 7) << 4)))
#define SBAR() __builtin_amdgcn_sched_barrier(0)
__device__ __forceinline__ int crow(int r, int hi) { return (r & 3) + 8 * (r >> 2) + 4 * hi; }
__device__ __forceinline__ unsigned cvtpk(float lo, float hi) { unsigned r; asm volatile("v_cvt_pk_bf16_f32 %0, %1, %2" : "=v"(r) : "v"(lo), "v"(hi)); return r; }
__device__ __forceinline__ void partialSM(f32x16& p0, f32x16& p1, float& m_reg, float& mn, float& alpha) {
  constexpr float C = SCALE * 1.4426950408889634f;
  float pmax = p0[0];
#pragma unroll
  for (int r = 1; r < 16; ++r) pmax = fmaxf(pmax, p0[r]);
#pragma unroll
  for (int r = 0; r < 16; ++r) pmax = fmaxf(pmax, p1[r]);
  { auto rr = __builtin_amdgcn_permlane32_swap(__float_as_uint(pmax), __float_as_uint(pmax), false, false);
    pmax = fmaxf(__uint_as_float(rr[0]), __uint_as_float(rr[1])); }
  if (__builtin_expect(__all(pmax - m_reg <= THR / SCALE), 1)) { mn = m_reg; alpha = 1.f; }
  else { mn = fmaxf(m_reg, pmax); alpha = __builtin_amdgcn_exp2f((m_reg - mn) * C); m_reg = mn; }
  const float mnC = -mn * C;
#pragma unroll
  for (int r = 0; r < 16; ++r) p0[r] = fmaf(p0[r], C, mnC);
#pragma unroll
  for (int r = 0; r < 16; ++r) p1[r] = fmaf(p1[r], C, mnC);
#pragma unroll
  for (int r = 0; r < 16; ++r) p0[r] = __builtin_amdgcn_exp2f(p0[r]);
}
__device__ __forceinline__ void finishSM(f32x16& p0, f32x16& p1, float alpha, float& l_reg, bf16x8& pa0, bf16x8& pa1, bf16x8& pa2, bf16x8& pa3) {
#pragma unroll
  for (int r = 0; r < 16; ++r) p1[r] = __builtin_amdgcn_exp2f(p1[r]);
  float ps = 0;
#pragma unroll
  for (int r = 0; r < 16; ++r) ps += p0[r];
#pragma unroll
  for (int r = 0; r < 16; ++r) ps += p1[r];
  { auto rr = __builtin_amdgcn_permlane32_swap(__float_as_uint(ps), __float_as_uint(ps), false, false);
    ps = __uint_as_float(rr[0]) + __uint_as_float(rr[1]); }
  l_reg = l_reg * alpha + ps;
#define PK4(P, BASE, OUT) do { unsigned a0 = cvtpk(P[BASE + 0], P[BASE + 1]), a1 = cvtpk(P[BASE + 2], P[BASE + 3]);   \
    unsigned b0 = cvtpk(P[BASE + 4], P[BASE + 5]), b1 = cvtpk(P[BASE + 6], P[BASE + 7]);                              \
    auto r0 = __builtin_amdgcn_permlane32_swap(a0, b0, false, false); auto r1 = __builtin_amdgcn_permlane32_swap(a1, b1, false, false); \
    u32x4 w = {r0[0], r1[0], r0[1], r1[1]}; OUT = __builtin_bit_cast(bf16x8, w); } while (0)
  PK4(p0, 0, pa0); PK4(p0, 8, pa1); PK4(p1, 0, pa2); PK4(p1, 8, pa3);
#undef PK4
}
__device__ __forceinline__ void qkt(f32x16& p0, f32x16& p1, lds_cptr Kn, lds_cptr Kr, const bf16x8 (&qr)[12], int r32, int hi) {
  p0 = f32x16{}; p1 = f32x16{};
#pragma unroll
  for (int d0 = 0; d0 < 8; ++d0) { const int cb = (d0 * 16 + hi * 8) * 2;
    const bf16x8 b0 = *(LAS const bf16x8*)(Kn + KSWZ(r32, cb)); const bf16x8 b1 = *(LAS const bf16x8*)(Kn + KSWZ(32 + r32, cb));
    p0 = __builtin_amdgcn_mfma_f32_32x32x16_bf16(b0, qr[d0], p0, 0, 0, 0);
    p1 = __builtin_amdgcn_mfma_f32_32x32x16_bf16(b1, qr[d0], p1, 0, 0, 0); }
#pragma unroll
  for (int d0 = 0; d0 < 4; ++d0) { const int cb = (d0 * 16 + hi * 8) * 2;
    const bf16x8 b0 = *(LAS const bf16x8*)(Kr + RSWZ(r32, cb)); const bf16x8 b1 = *(LAS const bf16x8*)(Kr + RSWZ(32 + r32, cb));
    p0 = __builtin_amdgcn_mfma_f32_32x32x16_bf16(b0, qr[8 + d0], p0, 0, 0, 0);
    p1 = __builtin_amdgcn_mfma_f32_32x32x16_bf16(b1, qr[8 + d0], p1, 0, 0, 0); }
}
__device__ __forceinline__ int v_st(int k, int c) { const int kk = (k & ~0xC) | ((k & 4) << 1) | ((k & 8) >> 1); return ((kk >> 3) * 4 + (c >> 5)) * 512 + ((kk & 7) * 32 + (c & 31)) * 2; }
__device__ __forceinline__ int v_rd_base(int lane) { return ((lane & 3) << 3) | (((lane >> 2) & 3) << 6) | (((lane >> 4) & 1) << 5) | (((lane >> 5) & 1) << 8); }
constexpr int v_rd_off(int d0, int ks, int half) { return d0 * 512 + ks * 4096 + half * 2048; }
template <int OFF> __device__ __forceinline__ s16x4 tr_read(lds_cptr vb) { return __builtin_bit_cast(s16x4, __builtin_amdgcn_ds_read_tr16_b64_v4i16((LAS v4i16_t*)(vb + OFF))); }
template <int D0> __device__ __forceinline__ void pv_one(f32x16& od, lds_cptr vb, bf16x8 pa0, bf16x8 pa1, bf16x8 pa2, bf16x8 pa3) {
  const s16x4 l0 = tr_read<v_rd_off(D0, 0, 0)>(vb), h0 = tr_read<v_rd_off(D0, 0, 1)>(vb), l1 = tr_read<v_rd_off(D0, 1, 0)>(vb), h1 = tr_read<v_rd_off(D0, 1, 1)>(vb);
  const s16x4 l2 = tr_read<v_rd_off(D0, 2, 0)>(vb), h2 = tr_read<v_rd_off(D0, 2, 1)>(vb), l3 = tr_read<v_rd_off(D0, 3, 0)>(vb), h3 = tr_read<v_rd_off(D0, 3, 1)>(vb);
#define PK(L, H) (bf16x8){L[0], L[1], L[2], L[3], H[0], H[1], H[2], H[3]}
  od = __builtin_amdgcn_mfma_f32_32x32x16_bf16(pa0, PK(l0, h0), od, 0, 0, 0);
  od = __builtin_amdgcn_mfma_f32_32x32x16_bf16(pa1, PK(l1, h1), od, 0, 0, 0);
  od = __builtin_amdgcn_mfma_f32_32x32x16_bf16(pa2, PK(l2, h2), od, 0, 0, 0);
  od = __builtin_amdgcn_mfma_f32_32x32x16_bf16(pa3, PK(l3, h3), od, 0, 0, 0);
#undef PK
}
__device__ __forceinline__ void pv_d0(f32x16* o, lds_cptr vb, bf16x8 pa0, bf16x8 pa1, bf16x8 pa2, bf16x8 pa3) {
  pv_one<0>(o[0], vb, pa0, pa1, pa2, pa3); pv_one<1>(o[1], vb, pa0, pa1, pa2, pa3); pv_one<2>(o[2], vb, pa0, pa1, pa2, pa3); pv_one<3>(o[3], vb, pa0, pa1, pa2, pa3);
}
__device__ __forceinline__ void attn_unit(const bf16* __restrict__ Q, const bf16* __restrict__ KV, const bf16* __restrict__ KR, unsigned char* __restrict__ O, const float* __restrict__ rope_tab,
                                          int qrow0, int h, bool lat, int qpos0, int krow_a, int ntile_a, int krow_b, int NT, LAS unsigned char* lds) {
  const int tid = threadIdx.x, wid = tid >> 6, lane = tid & 63, r32 = lane & 31, hi = lane >> 5;
  lds_cptr V_lds = (lds_cptr)(lds + OFF_V), Kn_lds = (lds_cptr)(lds + OFF_KN), Kr_lds = (lds_cptr)(lds + OFF_KR);
  LAS float* wsf = (LAS float*)(lds + OFF_WS) + wid * 64; LAS float* li_l = wsf; LAS float* al_l = wsf + 32;
  float m_reg = -1e30f, l_reg = 0.f; f32x16 o[4] = {}; bf16x8 qr[12];
  const bf16* Qw = Q + (size_t)(qrow0 + wid * 32 + r32) * DQ + h * DQK + hi * 8;
#pragma unroll
  for (int d0 = 0; d0 < 12; ++d0) qr[d0] = *(const GAS bf16x8*)(Qw + d0 * 16);
  if (lat) {
    const int pos = qpos0 + wid * 32 + r32;
#pragma unroll
    for (int dd = 0; dd < 2; ++dd) {
      const float* ct = rope_tab + pos * 32 + dd * 16 + hi * 8; const float* st = ct + S_LAT * 32;
      const f32x4 c0 = *(const GAS f32x4*)ct, c1 = *(const GAS f32x4*)(ct + 4), s0 = *(const GAS f32x4*)st, s1 = *(const GAS f32x4*)(st + 4);
      bf16x8 x1 = qr[8 + dd], x2 = qr[10 + dd]; float a[8], b[8];
#pragma unroll
      for (int e = 0; e < 8; ++e) { a[e] = __uint_as_float(((unsigned)(unsigned short)x1[e]) << 16); b[e] = __uint_as_float(((unsigned)(unsigned short)x2[e]) << 16); }
      u32x4 w1, w2;
#pragma unroll
      for (int e2 = 0; e2 < 4; ++e2) { const int e = 2 * e2; const float cA = e < 4 ? c0[e] : c1[e - 4], cB = e + 1 < 4 ? c0[e + 1] : c1[e + 1 - 4], sA = e < 4 ? s0[e] : s1[e - 4], sB = e + 1 < 4 ? s0[e + 1] : s1[e + 1 - 4];
        w1[e2] = cvtpk(a[e] * cA - b[e] * sA, a[e + 1] * cB - b[e + 1] * sB); w2[e2] = cvtpk(a[e] * sA + b[e] * cA, a[e + 1] * sB + b[e + 1] * cB); }
      qr[8 + dd] = __builtin_bit_cast(bf16x8, w1); qr[10 + dd] = __builtin_bit_cast(bf16x8, w2);
    }
  }
  const int sr = tid >> 4, sc = (tid & 15) * 8, vst0 = v_st(sr, sc), vst1 = v_st(32 + sr, sc), kst0 = KSWZ(sr, sc * 2), kst1 = KSWZ(32 + sr, sc * 2);
  const int rr = tid >> 3, rc = (tid & 7) * 8, rst = RSWZ(rr, rc * 2);
  lds_cptr vb0 = V_lds + v_rd_base(lane);
  bf16x8 sv0, sv1, sk0, sk1, skr;
  const bf16* KVh = KV + h * (DNOPE + DVH);
#define KROW(j) ((j) < ntile_a ? krow_a + 64 * (j) : krow_b + 64 * ((j) - ntile_a))
#define SLOAD(j) do { const int k0_ = KROW(j); const bf16* p0_ = KVh + (size_t)(k0_ + sr) * DKV + sc; const bf16* p1_ = KVh + (size_t)(k0_ + 32 + sr) * DKV + sc; \
    sk0 = *(const GAS bf16x8*)p0_; sk1 = *(const GAS bf16x8*)p1_; sv0 = *(const GAS bf16x8*)(p0_ + DNOPE); sv1 = *(const GAS bf16x8*)(p1_ + DNOPE); \
    skr = *(const GAS bf16x8*)(KR + (size_t)(k0_ + rr) * DROPE + rc); } while (0)
#define SWRITE(b) do { *(LAS bf16x8*)((LAS char*)(lds + OFF_V) + (b) * SHM_V + vst0) = sv0; *(LAS bf16x8*)((LAS char*)(lds + OFF_V) + (b) * SHM_V + vst1) = sv1; \
    *(LAS bf16x8*)((LAS char*)(lds + OFF_KN) + (b) * SHM_KN + kst0) = sk0; *(LAS bf16x8*)((LAS char*)(lds + OFF_KN) + (b) * SHM_KN + kst1) = sk1; \
    *(LAS bf16x8*)((LAS char*)(lds + OFF_KR) + (b) * SHM_KR + rst) = skr; } while (0)
  SLOAD(0); VM_WAIT(); SWRITE(0);
  if (NT > 1) SLOAD(1);
  LDS_WAIT(); __syncthreads();
  for (int j = 0; j < NT; ++j) {
    const int buf = j & 1;
    f32x16 p0, p1; float mn, alpha; bf16x8 pa0, pa1, pa2, pa3;
    qkt(p0, p1, Kn_lds + buf * SHM_KN, Kr_lds + buf * SHM_KR, qr, r32, hi);
    partialSM(p0, p1, m_reg, mn, alpha);
    if (__any(alpha < 1.f)) { if (hi == 0) al_l[r32] = alpha; LDS_WAIT();
#pragma unroll
      for (int d = 0; d < 4; ++d)
#pragma unroll
        for (int r = 0; r < 16; ++r) o[d][r] *= al_l[crow(r, hi)]; }
    finishSM(p0, p1, alpha, l_reg, pa0, pa1, pa2, pa3);
    pv_d0(o, vb0 + buf * SHM_V, pa0, pa1, pa2, pa3);
    if (j + 1 < NT) { VM_WAIT(); SWRITE(buf ^ 1); if (j + 2 < NT) SLOAD(j + 2); }
    LDS_WAIT(); __syncthreads();
  }
  if (hi == 0) li_l[r32] = l_reg;
  LDS_WAIT();
  float rli[16];
#pragma unroll
  for (int r = 0; r < 16; ++r) rli[r] = __builtin_amdgcn_rcpf(li_l[crow(r, hi)]) * MIX_SCALE;
  unsigned char* Ow = O + (size_t)(qrow0 + wid * 32) * DM + h * DVH;
#pragma unroll
  for (int r = 0; r < 16; ++r) { const int orow = crow(r, hi);
#pragma unroll
    for (int d0 = 0; d0 < 4; ++d0) { const float ov = o[d0][r] * rli[r]; Ow[(size_t)orow * DM + d0 * 32 + r32] = (unsigned char)(__builtin_amdgcn_cvt_pk_fp8_f32(ov, ov, 0, false) & 0xff); } }
#undef KROW
#undef SLOAD
#undef SWRITE
}
#undef KSWZ
#undef RSWZ
#undef SBAR
}

constexpr int N_PHASES = 14;
struct Args { const float* in[21]; float* out; unsigned char* ws; int ph_lo, ph_hi; };
static_assert(sizeof(Args) == 192, "Args has no holes");
__global__ void __launch_bounds__(NWAVES * 64, 2) mk_fwd(Args args) {
    extern __shared__ __attribute__((aligned(16))) unsigned char lds_raw[];
    LAS unsigned char* lds = (LAS unsigned char*)lds_raw;
    volatile LAS unsigned* MISC = (volatile LAS unsigned*)(lds + MISC_OFF);
    const int tid = threadIdx.x, lane = tid & 63, wave = __builtin_amdgcn_readfirstlane(tid >> 6);
    const int G = gridDim.x, bid = blockIdx.x;
    unsigned char* ws = args.ws;
    gu32* ctl = (gu32*)(ws + WS_CTL);
    for (int u = tid; u < (LDS_BYTES - LDSCTL_OFF) / 4; u += NWAVES * 64) ((LAS unsigned*)(lds + LDSCTL_OFF))[u] = 0u;
    __syncthreads();
#if MK_ONE_LAUNCH
    XcdBarrier bar = xcd_barrier_post((unsigned*)(ctl + CW_BAR), MISC + 8);
#define GRID_BAR() xcd_barrier(bar)
#else
    (void)ctl; (void)MISC;
#define GRID_BAR() do { } while (0)
#endif
    const float* x_prompt = args.in[0]; const float* x_sample = args.in[1]; const float* cache_ckv = args.in[2]; const float* cache_krope = args.in[3];
    const float* c_in = args.in[4]; const float* c_ctx = args.in[5]; const float* w_ada = args.in[6]; const float* b_ada = args.in[7];
    const float* g_q = args.in[9]; const float* g_kv = args.in[11]; const float* pool_scale = args.in[14];
    const float* ln_gamma = args.in[19]; const float* ln_beta = args.in[20];
    float* out = args.out;
    float* mods = (float*)(ws + WS_MODS); const float* rope_tab = (const float*)(ws + WS_ROPE);
    bf16* WGU0 = (bf16*)(ws + WS_WGU0); bf16* WGU1 = (bf16*)(ws + WS_WGU1); bf16* WD0 = (bf16*)(ws + WS_WD0); bf16* WD1 = (bf16*)(ws + WS_WD1);
    bf16* WUQ = (bf16*)(ws + WS_WUQ); bf16* WUKV = (bf16*)(ws + WS_WUKV); bf16* WPOOL = (bf16*)(ws + WS_WPOOL); bf16* WOUT = (bf16*)(ws + WS_WOUT);
    bf16* U = (bf16*)(ws + WS_U); unsigned char* U8 = ws + WS_U; unsigned char* H8 = ws + WS_H; bf16* DEL = (bf16*)(ws + WS_PRE); bf16* DEL2 = (bf16*)(ws + WS_HP);     float* X1 = (float*)(ws + WS_X1); bf16* HQP = (bf16*)(ws + WS_HP); float* HK0 = (float*)(ws + WS_HP + 64 * MiB); float* HK1 = (float*)(ws + WS_HP + 96 * MiB);
    unsigned char* CQN = ws + WS_CQN; unsigned char* CKV = ws + WS_CKV; bf16* KR = (bf16*)(ws + WS_KR); unsigned char* POOLED = ws + WS_POOLED;
    bf16* Qb = (bf16*)(ws + WS_Q); bf16* KVb = (bf16*)(ws + WS_KV); unsigned char* MIXIN = ws + WS_MIXIN;
    const int gw = bid * NWAVES + wave, NGW = G * NWAVES;

    const int lo = args.ph_lo, hi = args.ph_hi;
#ifndef PH_MASK
#define PH_MASK 0x3fff
#endif
#define IN(k) (((PH_MASK >> (k)) & 1) && lo <= (k) && (k) < hi)
#define BOTH(k) (IN(k) && IN((k) + 1))
#ifndef PROBE_DUP
#define PROBE_DUP 0
#endif
#define REP(k) for (int rep_ = 0; rep_ < 1 + ((PROBE_DUP >> (k)) & 1); ++rep_)

    if (IN(0)) { REP(0) {
        p0_ada(c_ctx, c_in, w_ada, b_ada, rep_ ? (float*)(ws + WS_PRE) : mods, lds, tid, wave, lane, bid, G);
        __syncthreads();
        WPtrs P; P.w_in = args.in[8]; P.w_uq = args.in[10]; P.w_ukv = args.in[12]; P.w_pool = args.in[13]; P.w_out = args.in[15]; P.w_gate = args.in[16]; P.w_up = args.in[17]; P.w_down = args.in[18];
        p0_convert(P, ws, lds, tid, wave, lane, bid, G);
        }
        if (BOTH(0)) GRID_BAR();
    }
    if (IN(1)) { REP(1) {
        ln_phase<false, true, 1>(x_prompt, x_sample, nullptr, nullptr, nullptr, nullptr, mods, 0, 1, nullptr, nullptr, nullptr, U8, lds, tid, lane, gw, NGW);
        }
        if (BOTH(1)) GRID_BAR();
    }
    if (IN(2)) { REP(2) {
        pg8::Gemm g{(const bf16*)U8, WGU0, T, NGU, DM, DM, 0, 0}; pg8::StaticOrder S; S.init(T, NGU, G, bid, DM / 128);
        pg8::EpiSwigluF8 E{H8, DFF, 1.0f / WGU_SCALE};
        pg8::gemm_phase<pg8::EpiSwigluF8, pg8::StaticOrder, true, true>(lds + RING_OFF, g, S, E);
        { const int nun = (T / 256) * (NGU / 256), rem = nun - (nun / G) * G; if (bid >= rem) convert_wdown(args.in[18], (unsigned char*)WD0, lds, wave, lane, bid - rem, G - rem); }
        }
        if (BOTH(2)) GRID_BAR();
    }
    if (IN(3)) { REP(3) {
        pg8::Gemm g{(const bf16*)H8, WD0, T, DM, DFF, DFF, 0, 0}; pg8::SplitTailOrder S; S.init(T, T_CTX, DM, G, bid, DFF / 128, 44);
        pg8::EpiDelta E{mods + 2 * DM, 0.5f / WD_SCALE, DEL, DEL2};
        pg8::gemm_phase<pg8::EpiDelta, pg8::SplitTailOrder, true, true>(lds + RING_OFF, g, S, E);
        }
        if (BOTH(3)) GRID_BAR();
    }
    if (IN(4)) { REP(4) {
        ln_phase<true, true, 2>(x_prompt, x_sample, DEL, DEL2, ln_gamma + 0 * DM, ln_beta + 0 * DM, mods, 3, 4, X1, X1 + (size_t)T_CTX * DM, U, H8, lds, tid, lane, gw, NGW);
        }
        if (BOTH(4)) GRID_BAR();
    }
    if (IN(5)) { REP(5) {
        { pg8::Gemm g{(const bf16*)H8, (const bf16*)(ws + WS_WIN8), T, NIN8, DM, DM, 0, 0}; pg8::StaticOrder S; S.init(T, NIN8, G, bid, DM / 128);
          pg8::EpiBf16S E{HQP, NIN8, 0, nullptr, 1.0f / WIN_SCALE};
          pg8::gemm_phase<pg8::EpiBf16S, pg8::StaticOrder, true, true>(lds + RING_OFF, g, S, E); }
        { pg8::Gemm g{U, (const bf16*)(ws + WS_WINB), T, NINB, DM, DM, 0, 0};
          const int nfp8 = (T / 256) * (NIN8 / 256), q2 = nfp8 / G, nlight = G - (nfp8 - q2 * G);
          pg8::SplitAllOrder S; S.init(T, NINB, (bid + nlight) % G, 240 - nlight, DM / 128);
          pg8::EpiF32Part E{HK0, NINB, 0, HK1, NINB, NINB_REAL};
          pg8::gemm_phase<pg8::EpiF32Part, pg8::SplitAllOrder, true, false>(lds + RING_OFF, g, S, E); }
        }
        if (BOTH(5)) GRID_BAR();
    }
    if (IN(6)) { REP(6) {
        for (int m = gw; m < TKV; m += NGW) {
            if (m < T) p6_row(m, HQP, HK0, HK1, g_q, g_kv, rope_tab, out, CQN, CKV, KR, POOLED, lane);
            else { const int r = m - T;
#pragma unroll
                for (int j = 0; j < 2; ++j) st_fp8x4(CKV + (size_t)m * KVLORA + 4 * (lane + 64 * j), *(const GAS f32x4*)(cache_ckv + (size_t)r * KVLORA + 4 * (lane + 64 * j)));
                KR[(size_t)m * DROPE + lane] = (bf16)f2bf(cache_krope[(size_t)r * DROPE + lane]); }
        }
        }
        if (BOTH(6)) GRID_BAR();
    }
    if (IN(7)) { REP(7) {
        { pg8::Gemm g{(const bf16*)CQN, WUQ, T, DQ, QLORA, QLORA, 0, 0}; pg8::StaticOrder S; S.init(T, DQ, G, bid, QLORA / 128);
          pg8::EpiBf16S E{Qb, DQ, 0, nullptr, 1.0f / WUQ_SCALE};
          pg8::gemm_phase<pg8::EpiBf16S, pg8::StaticOrder, true, true>(lds + RING_OFF, g, S, E); }
        { pg8::Gemm g{(const bf16*)CKV, WUKV, TKV, DKV, KVLORA, KVLORA, 0, 0}; pg8::StaticOrder S; S.init(TKV, DKV, G, (bid + 32) % G, KVLORA / 128);
          pg8::EpiBf16S E{KVb, DKV, 0, nullptr, 1.0f / WUKV_SCALE};
          pg8::gemm_phase<pg8::EpiBf16S, pg8::StaticOrder, true, true>(lds + RING_OFF, g, S, E); }
        { pg8::Gemm g{(const bf16*)POOLED, WPOOL, T, POOLW, 512, POOLW, 1, 512}; pg8::StaticOrder S; S.init(T, POOLW, G, (bid + 128) % G, 512 / 128);
          pg8::EpiF8S E{MIXIN, DM, POOLW, pool_scale, MIX_SCALE / WPOOL_SCALE};
          pg8::gemm_phase<pg8::EpiF8S, pg8::StaticOrder, true, true>(lds + RING_OFF, g, S, E); }
        }
        if (BOTH(7)) GRID_BAR();
    }
    if (IN(8)) { REP(8) {
        for (int vu = bid; vu < 256; vu += G) {
            const bool lat = vu < 128; const int nsub = lat ? 1 : 4;
            for (int i = 0; i < nsub; ++i) {
                int qrow0, h, qpos0, krow_a, nta, krow_b, NT;
                if (lat) { const int b = vu >> 6, qb = vu & 3; h = (vu >> 2) & 15; qrow0 = T_CTX + b * S_LAT + qb * 256; qpos0 = qb * 256; krow_a = T_CTX + b * S_LAT; nta = S_LAT / 64; krow_b = T + b * PAST; NT = (S_LAT + PAST) / 64; }
                else { const int idx = (vu - 128) * 4 + i, b = idx >> 4; h = idx & 15; qrow0 = b * S_CTX; qpos0 = 0; krow_a = b * S_CTX; nta = S_CTX / 64; krow_b = 0; NT = S_CTX / 64; }
                att::attn_unit(Qb, KVb, KR, MIXIN, rope_tab, qrow0, h, lat, qpos0, krow_a, nta, krow_b, NT, lds + RING_OFF);
            }
        }
        }
        if (BOTH(8)) GRID_BAR();
    }
    if (IN(9)) { REP(9) {
        pg8::Gemm g{(const bf16*)MIXIN, WOUT, T, DM, DM, DM, 0, 0}; pg8::SplitTailOrder S; S.init(T, T_CTX, DM, G, bid, DM / 128, 16);
        pg8::EpiDelta E{mods + 5 * DM, 1.0f / (WOUT_SCALE * MIX_SCALE), DEL, DEL2};
        pg8::gemm_phase<pg8::EpiDelta, pg8::SplitTailOrder, true, true>(lds + RING_OFF, g, S, E);
        }
        if (BOTH(9)) GRID_BAR();
    }
    if (IN(10)) { REP(10) {
        ln_phase<true, true, 1>(X1, X1 + (size_t)T_CTX * DM, DEL, DEL2, ln_gamma + 1 * DM, ln_beta + 1 * DM, mods, 6, 7, X1, X1 + (size_t)T_CTX * DM, nullptr, U8, lds, tid, lane, gw, NGW);
        }
        if (BOTH(10)) GRID_BAR();
    }
    if (IN(11)) { REP(11) {
        pg8::Gemm g{(const bf16*)U8, WGU1, T, NGU, DM, DM, 0, 0}; pg8::StaticOrder S; S.init(T, NGU, G, bid, DM / 128);
        pg8::EpiSwigluF8 E{H8, DFF, 1.0f / WGU_SCALE};
        pg8::gemm_phase<pg8::EpiSwigluF8, pg8::StaticOrder, true, true>(lds + RING_OFF, g, S, E);
        { const int nun = (T / 256) * (NGU / 256), rem = nun - (nun / G) * G; if (bid >= rem) convert_wdown(args.in[18] + (size_t)DFF * DM, (unsigned char*)WD1, lds, wave, lane, bid - rem, G - rem); }
        }
        if (BOTH(11)) GRID_BAR();
    }
    if (IN(12)) { REP(12) {
        pg8::Gemm g{(const bf16*)H8, WD1, T, DM, DFF, DFF, 0, 0}; pg8::SplitTailOrder S; S.init(T, T_CTX, DM, G, bid, DFF / 128, 44);
        pg8::EpiDelta E{mods + 8 * DM, 0.5f / WD_SCALE, DEL, DEL2};
        pg8::gemm_phase<pg8::EpiDelta, pg8::SplitTailOrder, true, true>(lds + RING_OFF, g, S, E);
        }
        if (BOTH(12)) GRID_BAR();
    }
    if (IN(13)) { REP(13) {
        ln_phase<true, false, 0>(X1, X1 + (size_t)T_CTX * DM, DEL, DEL2, ln_gamma + 2 * DM, ln_beta + 2 * DM, mods, 0, 0, out, out + (size_t)T_CTX * DM, nullptr, nullptr, lds, tid, lane, gw, NGW); }
    }
#undef IN
#undef BOTH
}

extern "C" void kernel_launch(void* const* d_in, const int* in_sizes, int n_in, void* d_out, int out_size, void* d_ws, size_t ws_size, hipStream_t stream) {
    static int grid = 0;
    if (grid == 0) {
        if (n_in != 21 || (size_t)out_size != OUT_TOTAL || ws_size < WS_END) { fprintf(stderr, "kernel_launch: unexpected shapes: n_in %d out %d ws %zu (need %zu)\n", n_in, out_size, ws_size, (size_t)WS_END); grid = -1; return; }
        int dev = 0, cus = 0;
        if (hipGetDevice(&dev) != hipSuccess || hipDeviceGetAttribute(&cus, hipDeviceAttributeMultiprocessorCount, dev) != hipSuccess) { fprintf(stderr, "kernel_launch: device query failed\n"); grid = -1; return; }
        if (hipFuncSetAttribute((const void*)mk_fwd, hipFuncAttributeMaxDynamicSharedMemorySize, LDS_BYTES) != hipSuccess) { fprintf(stderr, "kernel_launch: hipFuncSetAttribute failed\n"); grid = -1; return; }
        (void)hipGetLastError();
        grid = cus;
    }
    if (grid < 0) return;
    if (hipMemsetAsync((char*)d_ws + WS_CTL, 0, CTL_ZERO_BYTES, stream) != hipSuccess) { fprintf(stderr, "kernel_launch: memset failed\n"); return; }
    Args a{};
    for (int i = 0; i < 21; ++i) a.in[i] = (const float*)d_in[i];
    a.out = (float*)d_out; a.ws = (unsigned char*)d_ws;
#if MK_ONE_LAUNCH
    a.ph_lo = 0; a.ph_hi = N_PHASES;
    hipLaunchKernelGGL(mk_fwd, dim3(grid), dim3(NWAVES * 64), LDS_BYTES, stream, a);
#else
    for (int ph = 0; ph < N_PHASES; ++ph) { a.ph_lo = ph; a.ph_hi = ph + 1; hipLaunchKernelGGL(mk_fwd, dim3(grid), dim3(NWAVES * 64), LDS_BYTES, stream, a); }
#endif
    const hipError_t le = hipPeekAtLastError();
    if (le != hipSuccess) fprintf(stderr, "kernel_launch: launch failed: %s\n", hipGetErrorName(le));
}
```

```cpp
#include <hip/hip_runtime.h>
#include <cstdio>
#include <cstdint>

#ifndef MK_ONE_LAUNCH
#define MK_ONE_LAUNCH 1
#endif

namespace pg8 {
#define PG8_LAS __attribute__((address_space(3)))
typedef unsigned short bf16_t;
typedef short bf16x8 __attribute__((ext_vector_type(8)));
typedef float f32x4 __attribute__((ext_vector_type(4)));
typedef unsigned u32x4 __attribute__((ext_vector_type(4)));
constexpr int BM = 256, BK = 64, HALF = 128, HTB = HALF * BK * 2  , STAGE_BYTES = 8 * HTB, NXCD = 8, WGM = 8;

__host__ __device__ __forceinline__ int lds_byte(int r, int c) { const int st = (r >> 4) * 2 + (c >> 5), rr = r & 15, cc = c & 31, ob = rr * 64 + cc * 2; return st * 1024 + (ob ^ (((ob >> 9) & 1) << 5)); }
__host__ __device__ __forceinline__ void stage_rc(int b, int& R, int& C) { const int st = b / 1024, sb = b % 1024, swz = sb ^ (((sb >> 9) & 1) << 5); R = (st >> 1) * 16 + swz / 64; C = (st & 1) * 32 + (swz % 64) / 2; }
__host__ __device__ __forceinline__ int perm32(int rho) { const int n = rho >> 4, i = rho & 15; return 8 * (i >> 2) + 4 * n + (i & 3); }

struct Unit { int pm, pn, k0, nk, kh; };
struct Gemm { const bf16_t* A; const bf16_t* Bt; int M, N, K, lda, ag_shift, ag_stride; };

struct StaticOrder {
    int nM, nN, nwg, G, c, nk;
    __host__ __device__ void init(int M, int N, int G_, int c_, int nk_) { nM = M / BM; nN = N / BM; nwg = nM * nN; G = G_; c = c_; nk = nk_; }
    __host__ __device__ __forceinline__ void map(int L, int& pm, int& pn) const {
        int wgid = L; { const int q = nwg / NXCD, r = nwg % NXCD, xcd = wgid % NXCD, off = wgid / NXCD; wgid = (xcd < r ? xcd * (q + 1) : r * (q + 1) + (xcd - r) * q) + off; }
        const int nig = WGM * nN, gid = wgid / nig, fm = gid * WGM, gsz = (nM - fm) < WGM ? (nM - fm) : WGM;
        pm = fm + ((wgid % nig) % gsz); pn = (wgid % nig) / gsz;
    }
    __host__ __device__ __forceinline__ bool next(int i, Unit& u) const { const long L = (long)i * G + c; if (L >= nwg) return false; int pm, pn; map((int)L, pm, pn); u.pm = pm; u.pn = pn; u.k0 = 0; u.nk = nk; u.kh = 0; return true; }
    __device__ __forceinline__ void a_ready(const Unit&) const {}
    __device__ __forceinline__ void done(const Unit&) const {}
};
struct SplitTailOrder {
    StaticOrder so; int ntail, nN, mfull, nk0, nk1;
    __host__ __device__ void init(int M, int Mfull, int N, int G_, int c_, int nk_, int nk0_) { so.init(Mfull, N, G_, c_, nk_); nN = N / BM; mfull = Mfull / BM; ntail = 2 * (M / BM - mfull) * nN; nk0 = nk0_; nk1 = nk_ - nk0_; }
    __host__ __device__ __forceinline__ bool next(int i, Unit& u) const {
        const long L0 = (long)i * so.G + so.c; if (L0 >= (long)so.nwg + ntail) return false;
        const bool full = L0 < so.nwg; const int Lf = full ? (int)L0 : 0, l = full ? 0 : (int)(L0 - so.nwg);
        int pmf, pnf; so.map(Lf, pmf, pnf);
        const int r = l / nN, kh = full ? 0 : (r & 1);
        u.pm = full ? pmf : mfull + (r >> 1); u.pn = full ? pnf : l % nN; u.kh = kh; u.k0 = kh ? nk0 : 0; u.nk = full ? so.nk : (kh ? nk1 : nk0); return true;
    }
    __device__ __forceinline__ void a_ready(const Unit&) const {}
    __device__ __forceinline__ void done(const Unit&) const {}
};

struct SplitAllOrder {
    int nN, ntot, n0, cr, nkh;
    __host__ __device__ void init(int M, int N, int cr_, int n0_, int nkh_) { nN = N / BM; ntot = 2 * (M / BM) * nN; n0 = n0_; cr = cr_; nkh = nkh_; }
    __host__ __device__ __forceinline__ bool next(int i, Unit& u) const {
        int l; if (i == 0) { if (cr >= n0) return false; l = cr; } else if (i == 1) { if (cr >= ntot - n0) return false; l = n0 + cr; } else return false;
        const int kh = l & 1, t = l >> 1; u.pn = t % nN; u.pm = t / nN; u.kh = kh; u.k0 = kh ? nkh : 0; u.nk = nkh; return true;
    }
    __device__ __forceinline__ void a_ready(const Unit&) const {}
    __device__ __forceinline__ void done(const Unit&) const {}
};

__device__ __forceinline__ unsigned cvt_pk_bf16(float lo, float hi) { unsigned r; asm volatile("v_cvt_pk_bf16_f32 %0, %1, %2" : "=v"(r) : "v"(lo), "v"(hi)); return r; }

constexpr int D_MODEL = 4096, N_MODS = 9 * D_MODEL;
constexpr int PM_SAMPLE0 = 32;
__device__ __forceinline__ int mset_of_pm(int pm) { return pm < PM_SAMPLE0 ? 0 : 1 + ((pm - PM_SAMPLE0) >> 2); }

__device__ __forceinline__ float silu_f(float g) { return g * __builtin_amdgcn_rcpf(1.0f + __builtin_amdgcn_exp2f(g * -1.4426950408889634f)); }

typedef unsigned u32x2 __attribute__((ext_vector_type(2)));
typedef short v2s16 __attribute__((ext_vector_type(2)));
__device__ __forceinline__ unsigned pk4_fp8_sc(float a, float b, float c, float d, float dscale) { v2s16 w = {0, 0}; w = __builtin_amdgcn_cvt_scalef32_pk_fp8_f32(w, a, b, dscale, false); w = __builtin_amdgcn_cvt_scalef32_pk_fp8_f32(w, c, d, dscale, true); return __builtin_bit_cast(unsigned, w); }
__device__ __forceinline__ unsigned pk4_fp8(float a, float b, float c, float d) { int w = 0; w = __builtin_amdgcn_cvt_pk_fp8_f32(a, b, w, false); w = __builtin_amdgcn_cvt_pk_fp8_f32(c, d, w, true); return (unsigned)w; }
struct EpiSwigluF8 {
    static constexpr bool PERM = true, AFTER_DRAIN = false;
    unsigned char* O; int ldc; float ws;
    __device__ __forceinline__ void operator()(const f32x4 (&acc)[2][2][4][2], const Unit& u, int wr, int wc, int fr, int fq) const {
        int lrow = wr * 64 + fr; asm volatile("" : "+v"(lrow));
        const int row0 = u.pm * BM + lrow, col0 = u.pn * HALF + wc * 32 + 8 * fq;
        const float c1 = -1.4426950408889634f * ws, dsc = 1.0f / (ws * ws);
#pragma unroll
        for (int ai = 0; ai < 2; ++ai)
#pragma unroll
            for (int m = 0; m < 4; ++m) { unsigned char* rowp = O + (size_t)(row0 + ai * HALF + m * 16) * ldc + col0;
                const f32x4 ag0 = acc[ai][0][m][0], ag1 = acc[ai][0][m][1], au0 = acc[ai][1][m][0], au1 = acc[ai][1][m][1];
                const f32x4 x0 = ag0 * c1, x1 = ag1 * c1; f32x4 r0, r1;
#pragma unroll
                for (int j = 0; j < 4; ++j) { r0[j] = __builtin_amdgcn_exp2f(x0[j]); r1[j] = __builtin_amdgcn_exp2f(x1[j]); }
                r0 = r0 + 1.0f; r1 = r1 + 1.0f;
#pragma unroll
                for (int j = 0; j < 4; ++j) { r0[j] = __builtin_amdgcn_rcpf(r0[j]); r1[j] = __builtin_amdgcn_rcpf(r1[j]); }
                const f32x4 h0 = (ag0 * au0) * r0, h1 = (ag1 * au1) * r1;
                u32x2 w; w.x = pk4_fp8_sc(h0[0], h0[1], h0[2], h0[3], dsc); w.y = pk4_fp8_sc(h1[0], h1[1], h1[2], h1[3], dsc);
                *(u32x2*)rowp = w; }
    }
};
struct EpiDelta {
    static constexpr bool PERM = true, AFTER_DRAIN = false;
    const float* gate; float gsc; bf16_t* out; bf16_t* out2;
    __device__ __forceinline__ void operator()(const f32x4 (&acc)[2][2][4][2], const Unit& u, int wr, int wc, int fr, int fq) const {
        bf16_t* const o1_ = out; bf16_t* const o2_ = out2; const float gs_ = gsc;
        const float* gp = gate + (size_t)mset_of_pm(u.pm) * N_MODS;
        int rl0 = wr * 64 + fr; asm volatile("" : "+v"(rl0));
        const int col0 = u.pn * BM + wc * 32 + 8 * fq;
        f32x4 gv[2][2];
#pragma unroll
        for (int bj = 0; bj < 2; ++bj)
#pragma unroll
            for (int n = 0; n < 2; ++n) gv[bj][n] = *(const f32x4*)(gp + col0 + bj * HALF + 4 * n) * gs_;
        bf16_t* base = u.kh ? o2_ + (size_t)((u.pm - PM_SAMPLE0) * BM + rl0) * D_MODEL + col0 : o1_ + (size_t)(u.pm * BM + rl0) * D_MODEL + col0;
#pragma unroll
        for (int ai = 0; ai < 2; ++ai)
#pragma unroll
            for (int m = 0; m < 4; ++m) { bf16_t* rowp = base + (size_t)(ai * HALF + m * 16) * D_MODEL;
#pragma unroll
                for (int bj = 0; bj < 2; ++bj) { const f32x4 v0 = acc[ai][bj][m][0] * gv[bj][0], v1 = acc[ai][bj][m][1] * gv[bj][1];
                    u32x4 w; w.x = cvt_pk_bf16(v0[0], v0[1]); w.y = cvt_pk_bf16(v0[2], v0[3]); w.z = cvt_pk_bf16(v1[0], v1[1]); w.w = cvt_pk_bf16(v1[2], v1[3]);
                    *(u32x4*)(rowp + bj * HALF) = w; } }
    }
};
struct EpiF32 {
    static constexpr bool PERM = false, AFTER_DRAIN = false;
    float* C; int ldc;
    __device__ __forceinline__ void operator()(const f32x4 (&acc)[2][2][4][2], const Unit& u, int wr, int wc, int fr, int fq) const {
        const int row0 = u.pm * BM + wr * 64 + fr, col0 = u.pn * BM + wc * 32 + 4 * fq;
#pragma unroll
        for (int ai = 0; ai < 2; ++ai)
#pragma unroll
            for (int m = 0; m < 4; ++m) { float* rowp = C + (size_t)(row0 + ai * HALF + m * 16) * ldc + col0;
#pragma unroll
                for (int bj = 0; bj < 2; ++bj)
#pragma unroll
                    for (int n = 0; n < 2; ++n) *(f32x4*)(rowp + bj * HALF + n * 16) = acc[ai][bj][m][n]; }
    }
};
struct EpiF32Map {
    static constexpr bool PERM = false, AFTER_DRAIN = false;
    float* C; int ldc; float s;
    __device__ __forceinline__ void operator()(const f32x4 (&acc)[2][2][4][2], const Unit& u, int wr, int wc, int fr, int fq) const {
        int lrow = wr * 64 + fr; asm volatile("" : "+v"(lrow));
        const int row0 = u.pm * BM + lrow, col0 = (u.pn < 4 ? u.pn * BM : 1600 + (u.pn - 4) * BM) + wc * 32 + 4 * fq; const float s_ = s;
#pragma unroll
        for (int ai = 0; ai < 2; ++ai)
#pragma unroll
            for (int m = 0; m < 4; ++m) { float* rowp = C + (size_t)(row0 + ai * HALF + m * 16) * ldc + col0;
#pragma unroll
                for (int bj = 0; bj < 2; ++bj)
#pragma unroll
                    for (int n = 0; n < 2; ++n) *(f32x4*)(rowp + bj * HALF + n * 16) = acc[ai][bj][m][n] * s_; }
    }
};
struct EpiF32Part {
    static constexpr bool PERM = false, AFTER_DRAIN = false;
    float* C0; int ld0, off0; float* C1; int ld1, ncols;
    __device__ __forceinline__ void operator()(const f32x4 (&acc)[2][2][4][2], const Unit& u, int wr, int wc, int fr, int fq) const {
        float* const c0_ = C0; float* const c1_ = C1; const int l0_ = ld0, l1_ = ld1, o0_ = off0, nc_ = ncols;
        int lrow = wr * 64 + fr; asm volatile("" : "+v"(lrow));
        const int row0 = u.pm * BM + lrow, colw = u.pn * BM + wc * 32;
        float* base = u.kh ? c1_ + (size_t)row0 * l1_ + colw + 4 * fq : c0_ + (size_t)row0 * l0_ + o0_ + colw + 4 * fq; const size_t ld = u.kh ? (size_t)l1_ : (size_t)l0_;
#pragma unroll
        for (int bj = 0; bj < 2; ++bj) { if (colw + bj * HALF >= nc_) continue;
#pragma unroll
            for (int ai = 0; ai < 2; ++ai)
#pragma unroll
                for (int m = 0; m < 4; ++m) { float* rowp = base + (size_t)(ai * HALF + m * 16) * ld + bj * HALF;
#pragma unroll
                    for (int n = 0; n < 2; ++n) *(f32x4*)(rowp + n * 16) = acc[ai][bj][m][n]; } }
    }
};
struct EpiBf16S {
    static constexpr bool PERM = true, AFTER_DRAIN = false;
    bf16_t* O; int ldc, col_off; const float* cscale; float s;
    __device__ __forceinline__ void operator()(const f32x4 (&acc)[2][2][4][2], const Unit& u, int wr, int wc, int fr, int fq) const {
        const int row0 = u.pm * BM + wr * 64 + fr, col0 = u.pn * BM + wc * 32 + 8 * fq;
        f32x4 sv[2][2];
#pragma unroll
        for (int bj = 0; bj < 2; ++bj)
#pragma unroll
            for (int n = 0; n < 2; ++n) sv[bj][n] = (cscale ? *(const f32x4*)(cscale + col0 + bj * HALF + 4 * n) : (f32x4){1.f, 1.f, 1.f, 1.f}) * s;
#pragma unroll
        for (int ai = 0; ai < 2; ++ai)
#pragma unroll
            for (int m = 0; m < 4; ++m) { bf16_t* rowp = O + (size_t)(row0 + ai * HALF + m * 16) * ldc + col_off + col0;
#pragma unroll
                for (int bj = 0; bj < 2; ++bj) { const f32x4 v0 = acc[ai][bj][m][0] * sv[bj][0], v1 = acc[ai][bj][m][1] * sv[bj][1];
                    u32x4 w; w.x = cvt_pk_bf16(v0[0], v0[1]); w.y = cvt_pk_bf16(v0[2], v0[3]); w.z = cvt_pk_bf16(v1[0], v1[1]); w.w = cvt_pk_bf16(v1[2], v1[3]);
                    *(u32x4*)(rowp + bj * HALF) = w; } }
    }
};

struct EpiF8S {
    static constexpr bool PERM = true, AFTER_DRAIN = false;
    unsigned char* O; int ldc, col_off; const float* cscale; float s;
    __device__ __forceinline__ void operator()(const f32x4 (&acc)[2][2][4][2], const Unit& u, int wr, int wc, int fr, int fq) const {
        int lrow = wr * 64 + fr; asm volatile("" : "+v"(lrow));
        const int row0 = u.pm * BM + lrow, col0 = u.pn * BM + wc * 32 + 8 * fq;
        f32x4 sv[2][2];
#pragma unroll
        for (int bj = 0; bj < 2; ++bj)
#pragma unroll
            for (int n = 0; n < 2; ++n) sv[bj][n] = *(const f32x4*)(cscale + col0 + bj * HALF + 4 * n) * s;
#pragma unroll
        for (int ai = 0; ai < 2; ++ai)
#pragma unroll
            for (int m = 0; m < 4; ++m) { unsigned char* rowp = O + (size_t)(row0 + ai * HALF + m * 16) * ldc + col_off + col0;
#pragma unroll
                for (int bj = 0; bj < 2; ++bj) { const f32x4 v0 = acc[ai][bj][m][0] * sv[bj][0], v1 = acc[ai][bj][m][1] * sv[bj][1];
                    u32x2 w; w.x = pk4_fp8(v0[0], v0[1], v0[2], v0[3]); w.y = pk4_fp8(v1[0], v1[1], v1[2], v1[3]);
                    *(u32x2*)(rowp + bj * HALF) = w; } }
    }
};

typedef int v8i32 __attribute__((ext_vector_type(8)));
typedef int v4i32 __attribute__((ext_vector_type(4)));
struct Frag2 { bf16x8 k[2]; };
template <bool F8> struct FragT { typedef Frag2 T; };
template <> struct FragT<true> { typedef v8i32 T; };
template <class Epi, class Sched, bool ALIGN_EPI = false, bool F8 = false>
__device__ __forceinline__ void gemm_phase(PG8_LAS unsigned char* lds, const Gemm g, const Sched& S, const Epi& E) {
    const int tid = threadIdx.x, wid = __builtin_amdgcn_readfirstlane(tid >> 6), lane = tid & 63, wr = wid >> 2, wc = wid & 3, fr = lane & 15, fq = lane >> 4;
    const int K = g.K, lda = g.lda; constexpr int EB = F8 ? 1 : 2;
    unsigned voffA[2], voffB[2];
#pragma unroll
    for (int i = 0; i < 2; ++i) { int R, C; stage_rc(tid * 16 + i * 8192, R, C); const int Rb = Epi::PERM ? ((R & ~31) + perm32(R & 31)) : R;
        voffA[i] = (unsigned)(R * lda) * (unsigned)EB + (unsigned)C * 2u; voffB[i] = (unsigned)(Rb * K) * (unsigned)EB + (unsigned)C * 2u; }
    const size_t kstep = (size_t)(BK * 2);
    const size_t hstepA = (size_t)HALF * lda * EB, hstepB = (size_t)HALF * K * EB;
    const size_t tstepA = 2 * hstepA, tstepB = 2 * hstepB;
    const unsigned ldsw = (unsigned)wid * 1024u;
    const int aoff = lds_byte(wr * 64 + fr, fq * 8); int boff = lds_byte(wc * 32 + fr, fq * 8) + 4 * HTB;
    asm volatile("" : "+v"(boff));
#define PG8_SA(b, h) (((b) * 2 + (h)) * HTB)
#define PG8_SB(b, h) ((4 + (b) * 2 + (h)) * HTB)
#define PG8_SBR(b, h) (((b) * 2 + (h)) * HTB)
#define PG8_STAGE(bufoff, gbase, voff) do { _Pragma("unroll") for (int _i = 0; _i < 2; ++_i) \
        __builtin_amdgcn_global_load_lds((const unsigned*)((const char*)(gbase) + (voff)[_i]), (PG8_LAS unsigned*)(lds + (bufoff) + ldsw + _i * 8192), 16, 0, 0); } while (0)
#define PG8_RD(off) (*(const PG8_LAS bf16x8*)(lds + (off)))
#define PG8_LDA(dst, b, h) do { _Pragma("unroll") for (int m = 0; m < 4; ++m) { if constexpr (F8) dst[m] = PG8_CAT(PG8_RD(PG8_SA(b, h) + aoff + m * 2048), PG8_RD(PG8_SA(b, h) + aoff + m * 2048 + 1024)); \
        else { dst[m].k[0] = PG8_RD(PG8_SA(b, h) + aoff + m * 2048); dst[m].k[1] = PG8_RD(PG8_SA(b, h) + aoff + m * 2048 + 1024); } } } while (0)
#define PG8_LDB(dst, b, h) do { _Pragma("unroll") for (int n = 0; n < 2; ++n) { if constexpr (F8) dst[n] = PG8_CAT(PG8_RD(PG8_SBR(b, h) + boff + n * 2048), PG8_RD(PG8_SBR(b, h) + boff + n * 2048 + 1024)); \
        else { dst[n].k[0] = PG8_RD(PG8_SBR(b, h) + boff + n * 2048); dst[n].k[1] = PG8_RD(PG8_SBR(b, h) + boff + n * 2048 + 1024); } } } while (0)
#define PG8_CAT(x, y) __builtin_shufflevector(__builtin_bit_cast(v4i32, x), __builtin_bit_cast(v4i32, y), 0, 1, 2, 3, 4, 5, 6, 7)
#define PG8_MMA(ai, bj, At, Bt) do { __builtin_amdgcn_s_setprio(1); _Pragma("unroll") for (int m = 0; m < 4; ++m) _Pragma("unroll") for (int n = 0; n < 2; ++n) { \
        if constexpr (F8) asm volatile("v_mfma_scale_f32_16x16x128_f8f6f4 %0, %1, %2, %0, %3, %3 op_sel_hi:[0,0,0]" : "+v"(acc[ai][bj][m][n]) : "v"(Bt[n]), "v"(At[m]), "v"(f8scl)); \
        else { _Pragma("unroll") for (int k = 0; k < 2; ++k) acc[ai][bj][m][n] = __builtin_amdgcn_mfma_f32_16x16x32_bf16(Bt[n].k[k], At[m].k[k], acc[ai][bj][m][n], 0, 0, 0); } } \
        __builtin_amdgcn_s_setprio(0); } while (0)
#define PG8_MMAZ(ai, bj, At, Bt) do { __builtin_amdgcn_s_setprio(1); _Pragma("unroll") for (int m = 0; m < 4; ++m) _Pragma("unroll") for (int n = 0; n < 2; ++n) { \
        asm volatile("v_mfma_scale_f32_16x16x128_f8f6f4 %0, %1, %2, 0, %3, %3 op_sel_hi:[0,0,0]" : "+v"(acc[ai][bj][m][n]) : "v"(Bt[n]), "v"(At[m]), "v"(f8scl)); } \
        __builtin_amdgcn_s_setprio(0); } while (0)
#define PG8_MMA0(z, ai, bj, At, Bt) do { if constexpr (F8) { if (z) PG8_MMAZ(ai, bj, At, Bt); else PG8_MMA(ai, bj, At, Bt); } else PG8_MMA(ai, bj, At, Bt); } while (0)
#define PG8_WAIT_V(n) asm volatile("s_waitcnt vmcnt(" #n ")" ::: "memory")
#define PG8_WAIT_L(n) asm volatile("s_waitcnt lgkmcnt(" #n ")" ::: "memory")
#define PG8_BAR __builtin_amdgcn_s_barrier()
#define PG8_SCHED __builtin_amdgcn_sched_barrier(0)
#define PG8_AOFF(u_) ((size_t)(u_).pm * tstepA + (size_t)((u_).pn >> g.ag_shift) * (size_t)g.ag_stride * EB + (size_t)(u_).k0 * kstep)
#define PG8_BOFF(u_) ((size_t)(u_).pn * tstepB + (size_t)(u_).k0 * kstep)
    Unit cur, nxt; int ui = 0;
    if (!S.next(0, cur)) return;
    const int f8scl = 0x7F7F7F7F;
    f32x4 acc[2][2][4][2];
    if constexpr (!F8) {
#pragma unroll
    for (int a = 0; a < 2; ++a)
#pragma unroll
        for (int b = 0; b < 2; ++b)
#pragma unroll
            for (int m = 0; m < 4; ++m)
#pragma unroll
                for (int n = 0; n < 2; ++n) acc[a][b][m][n] = (f32x4){0.f, 0.f, 0.f, 0.f};
    }
    typedef typename FragT<F8>::T frag_t;
    frag_t At[4], B0[2], B1[2];
    const char* cA = (const char*)g.A + PG8_AOFF(cur); const char* cB = (const char*)g.Bt + PG8_BOFF(cur);
    S.a_ready(cur);
    PG8_STAGE(PG8_SB(0, 0), cB, voffB); PG8_STAGE(PG8_SB(0, 1), cB + hstepB, voffB); PG8_STAGE(PG8_SA(0, 0), cA, voffA); PG8_STAGE(PG8_SA(0, 1), cA + hstepA, voffA);
    if (wr == 1) PG8_BAR;
    PG8_WAIT_V(2); PG8_BAR;
    PG8_STAGE(PG8_SB(1, 0), cB + kstep, voffB); PG8_STAGE(PG8_SA(1, 0), cA + kstep, voffA); PG8_STAGE(PG8_SB(1, 1), cB + hstepB + kstep, voffB);
    PG8_WAIT_V(6); PG8_BAR;
    for (;;) {
        const bool has_next = S.next(ui + 1, nxt);
        const char* nA = has_next ? (const char*)g.A + PG8_AOFF(nxt) : cA; const char* nB = has_next ? (const char*)g.Bt + PG8_BOFF(nxt) : cB;
        const int nt = cur.nk;
        for (int t = 0; t < nt; t += 2) {
            const bool last = (t == nt - 2);
            const char* a1 = cA + (size_t)(t + 1) * kstep;
            const char* a2 = last ? nA : cA + (size_t)(t + 2) * kstep; const char* b2 = last ? nB : cB + (size_t)(t + 2) * kstep;
            const char* a3 = a2 + kstep; const char* b3 = b2 + kstep;
            if (last && has_next) S.a_ready(nxt);
            PG8_LDB(B0, 0, 0); PG8_LDB(B1, 0, 1); PG8_SCHED; PG8_LDA(At, 0, 0); PG8_STAGE(PG8_SA(1, 1), a1 + hstepA, voffA);
            PG8_WAIT_V(8); PG8_WAIT_L(0); PG8_BAR; PG8_MMA0(t == 0, 0, 0, At, B0); PG8_MMA0(t == 0, 0, 1, At, B1); PG8_BAR; PG8_SCHED;
            PG8_LDA(At, 0, 1); PG8_STAGE(PG8_SB(0, 0), b2, voffB); PG8_STAGE(PG8_SB(0, 1), b2 + hstepB, voffB); PG8_STAGE(PG8_SA(0, 0), a2, voffA);
            PG8_WAIT_V(8); PG8_WAIT_L(0); PG8_BAR; PG8_MMA0(t == 0, 1, 0, At, B0); PG8_MMA0(t == 0, 1, 1, At, B1); PG8_BAR; PG8_SCHED;
            PG8_LDB(B0, 1, 0); PG8_LDB(B1, 1, 1); PG8_SCHED; PG8_LDA(At, 1, 0); PG8_STAGE(PG8_SA(0, 1), a2 + hstepA, voffA);
            PG8_WAIT_V(8); PG8_WAIT_L(0); PG8_BAR; PG8_MMA(0, 0, At, B0); PG8_MMA(0, 1, At, B1); PG8_BAR; PG8_SCHED;
            PG8_LDA(At, 1, 1); PG8_STAGE(PG8_SB(1, 0), b3, voffB); PG8_STAGE(PG8_SB(1, 1), b3 + hstepB, voffB); PG8_STAGE(PG8_SA(1, 0), a3, voffA);
            PG8_WAIT_V(8); PG8_WAIT_L(0); PG8_BAR; PG8_MMA(1, 0, At, B0); PG8_MMA(1, 1, At, B1); PG8_BAR; PG8_SCHED;
        }
        if constexpr (ALIGN_EPI) { if (wr == 0) PG8_BAR; }
        if constexpr (F8) asm volatile("s_nop 7\n\ts_nop 7\n\ts_nop 7" ::: "memory");
        E(acc, cur, wr, wc, fr, fq); S.done(cur);
        if (!has_next) break;
        if constexpr (!F8) {
#pragma unroll
        for (int a = 0; a < 2; ++a)
#pragma unroll
            for (int b = 0; b < 2; ++b)
#pragma unroll
                for (int m = 0; m < 4; ++m)
#pragma unroll
                    for (int n = 0; n < 2; ++n) acc[a][b][m][n] = (f32x4){0.f, 0.f, 0.f, 0.f};
        }
        cur = nxt; cA = nA; cB = nB; ++ui;
        if constexpr (ALIGN_EPI) { if (wr == 1) PG8_BAR; }
    }
    PG8_WAIT_V(0);
    if constexpr (!ALIGN_EPI) { if (wr == 0) PG8_BAR; }
    PG8_BAR;
#undef PG8_AOFF
#undef PG8_BOFF
#undef PG8_SA
#undef PG8_SB
#undef PG8_SBR
#undef PG8_STAGE
#undef PG8_LDA
#undef PG8_LDB
#undef PG8_MMA
#undef PG8_MMAZ
#undef PG8_MMA0
#undef PG8_CAT
#undef PG8_RD
#undef PG8_WAIT_V
#undef PG8_WAIT_L
#undef PG8_BAR
#undef PG8_SCHED
}
}

#define GAS __attribute__((address_space(1)))
#define LAS __attribute__((address_space(3)))
typedef unsigned short bf16;
typedef unsigned v4u __attribute__((ext_vector_type(4)));
typedef unsigned v2u __attribute__((ext_vector_type(2)));
typedef float f32x4 __attribute__((ext_vector_type(4)));
typedef short bf16x8 __attribute__((ext_vector_type(8)));
typedef GAS unsigned gu32;
#define RLX_AGENT __ATOMIC_RELAXED, __HIP_MEMORY_SCOPE_AGENT
#define LDS_WAIT() asm volatile("s_waitcnt lgkmcnt(0)" ::: "memory")
#define VM_WAIT() asm volatile("s_waitcnt vmcnt(0)" ::: "memory")
__device__ __forceinline__ unsigned f2bf(float f) { unsigned u = __builtin_bit_cast(unsigned, f); return (u + 0x7fffu + ((u >> 16) & 1u)) >> 16; }
__device__ __forceinline__ unsigned pk2(float lo, float hi) { return f2bf(lo) | (f2bf(hi) << 16); }

#define XB_TMO      128
#define XB_XCNT(j)  (256  + 64 * (j))
#define XB_XSUB(j)  (1280 + 64 * (j))
#define XB_XGEN(j)  (2304 + 64 * (j))
#define XB_TOP      3328
#define XB_TOPGEN   3392
#define XCD_BAR_WORDS 3456
#define XB_SPIN_CAP (1u << 18)

__device__ __forceinline__ unsigned xb_ld(unsigned* p)              { return __hip_atomic_load(p, __ATOMIC_RELAXED, __HIP_MEMORY_SCOPE_AGENT); }
__device__ __forceinline__ unsigned xb_add(unsigned* p, unsigned v) { return __hip_atomic_fetch_add(p, v, __ATOMIC_RELAXED, __HIP_MEMORY_SCOPE_AGENT); }
__device__ __forceinline__ unsigned xb_xcc_id() { return (unsigned)__builtin_amdgcn_s_getreg((3 << 11) | 20) & 0xFu; }
#define XB_SPIN(cond, bar) do { unsigned _sp = 0; while (cond) { __builtin_amdgcn_s_sleep(1); \
    if ((++_sp & 255u) == 0u) { if (xb_ld(&(bar)[XB_TMO])) break; if (_sp > XB_SPIN_CAP) { atomicAdd(&(bar)[XB_TMO], 1u); break; } } } } while (0)

struct XcdBarrier {
    unsigned* bar; unsigned x;
    volatile LAS unsigned* st;
};

__device__ __forceinline__ XcdBarrier xcd_barrier_post(unsigned* bar, volatile LAS unsigned* st) {
    XcdBarrier b; b.bar = bar; b.x = xb_xcc_id(); b.st = st;
    if (threadIdx.x == 0) (void)xb_add(&bar[XB_XCNT(b.x)], 1u);
    return b;
}
__device__ __forceinline__ void xcd_barrier_complete(unsigned* bar, unsigned x, unsigned& nloc, unsigned& nx) {
    const unsigned G = gridDim.x * gridDim.y * gridDim.z;
    unsigned sum, cnt, mine, sp = 0u;
    for (;;) {
        sum = 0u; cnt = 0u; mine = 0u;
#pragma unroll
        for (unsigned j = 0; j < 16; ++j) { const unsigned c = xb_ld(&bar[XB_XCNT(j)]); sum += c; cnt += (c > 0u) ? 1u : 0u; mine = (j == x) ? c : mine; }
        if (sum == G) break;
        __builtin_amdgcn_s_sleep(1);
        if ((++sp & 255u) == 0u) { if (xb_ld(&bar[XB_TMO])) break; if (sp > XB_SPIN_CAP) { atomicAdd(&bar[XB_TMO], 1u); break; } }
    }
    nloc = mine > 0u ? mine : 1u; nx = cnt > 0u ? cnt : 1u;
}

__device__ __forceinline__ void xcd_barrier(const XcdBarrier& b) {
    asm volatile("s_waitcnt vmcnt(0)" ::: "memory");
    __syncthreads();
    if (threadIdx.x == 0) {
        unsigned* bar = b.bar;
        __builtin_amdgcn_s_waitcnt(0);
        unsigned nloc = b.st[0], nx = b.st[1];
        if (nloc == 0u) { xcd_barrier_complete(bar, b.x, nloc, nx); b.st[0] = nloc; b.st[1] = nx; }
        const unsigned old = xb_add(&bar[XB_XSUB(b.x)], 1u);
        const unsigned gen = old / nloc;
        if (old + 1u == (gen + 1u) * nloc) {
            __builtin_amdgcn_fence(__ATOMIC_RELEASE, "agent");
            asm volatile("s_waitcnt vmcnt(0)" ::: "memory");
            const unsigned og = xb_add(&bar[XB_TOP], 1u);
            const unsigned tg = og / nx;
            if (og + 1u == (tg + 1u) * nx) xb_add(&bar[XB_TOPGEN], 1u);
            else XB_SPIN(xb_ld(&bar[XB_TOPGEN]) == tg, bar);
            __builtin_amdgcn_fence(__ATOMIC_ACQUIRE, "agent");
            xb_add(&bar[XB_XGEN(b.x)], 1u);
            asm volatile("s_waitcnt vmcnt(0)" ::: "memory");
        } else {
            XB_SPIN(xb_ld(&bar[XB_XGEN(b.x)]) == gen, bar);
            __builtin_amdgcn_fence(__ATOMIC_ACQUIRE, "agent");
            asm volatile("s_waitcnt vmcnt(0)" ::: "memory");
        }
    }
    __syncthreads();
}

constexpr int DM = 4096, T_CTX = 8192, T_LAT = 2048, T = T_CTX + T_LAT, S_CTX = 256, S_LAT = 1024, PAST = 256, NB_CTX = 32, NB_LAT = 2;
constexpr int NCACHE = NB_LAT * PAST, TKV = T + NCACHE;
constexpr int NH = 16, DQK = 192, DNOPE = 128, DROPE = 64, DVH = 128, DQ = NH * DQK  , DKV = NH * (DNOPE + DVH)  ;
constexpr int QLORA = 1024, KVLORA = 512, POOLW = 2048, INP = 3648, INP_PAD = 3840, DFF = 11008, NGU = 2 * DFF;
constexpr int NMOD = 9 * DM;
constexpr float LN_EPS = 1e-5f, RMS_EPS = 1e-6f, DN_ALPHA = 1.189207115002721f;
constexpr float WGU_SCALE = 64.f, WD_SCALE = 128.f, WOUT_SCALE = 128.f, WIN_SCALE = 64.f, WUQ_SCALE = 32.f, WUKV_SCALE = 16.f, WPOOL_SCALE = 16.f, MIX_SCALE = 16.f;
constexpr size_t OUT_CKV = (size_t)T * DM, OUT_KROPE = OUT_CKV + (size_t)T_CTX * KVLORA, OUT_TOTAL = OUT_KROPE + (size_t)T_CTX * DROPE;
static_assert(pg8::D_MODEL == DM && pg8::N_MODS == NMOD, "shape constants");

constexpr size_t MiB = 1u << 20;
constexpr size_t WS_CTL = 0, CTL_ZERO_BYTES = 2 * MiB;
constexpr size_t WS_MODS = 1 * MiB;
constexpr size_t WS_ROPE = 2 * MiB;
constexpr size_t WS_WGU0 = 4 * MiB, WS_WGU1 = 176 * MiB;
constexpr size_t WS_WD0 = 348 * MiB, WS_WD1 = 434 * MiB;
constexpr size_t WS_WIN = 520 * MiB, WS_WUQ = 550 * MiB, WS_WUKV = 556 * MiB, WS_WPOOL = 560 * MiB, WS_WOUT = 562 * MiB;
constexpr size_t WS_U = 594 * MiB;
constexpr size_t WS_H = 674 * MiB;
constexpr size_t WS_PRE = 890 * MiB;
constexpr size_t WS_X1 = 1050 * MiB;
constexpr size_t WS_HP = 1210 * MiB;
constexpr size_t WS_CQN = 1360 * MiB, WS_CKV = 1380 * MiB, WS_KR = 1391 * MiB, WS_POOLED = 1393 * MiB, WS_Q = 1433 * MiB, WS_KV = 1493 * MiB, WS_MIXIN = 1577 * MiB;
constexpr size_t WS_END = 1657 * MiB;
static_assert(WS_WGU0 + (size_t)NGU * DM * 2 <= WS_WGU1 && WS_WGU1 + (size_t)NGU * DM * 2 <= WS_WD0 && WS_WD0 + (size_t)DM * DFF * 2 <= WS_WD1 && WS_WD1 + (size_t)DM * DFF * 2 <= WS_WIN, "ws map 1");
static_assert(WS_WIN + (size_t)INP_PAD * DM * 2 <= WS_WUQ && WS_WUQ + (size_t)DQ * QLORA * 2 <= WS_WUKV && WS_WUKV + (size_t)DKV * KVLORA * 2 <= WS_WPOOL && WS_WPOOL + (size_t)POOLW * 512 * 2 <= WS_WOUT && WS_WOUT + (size_t)DM * DM * 2 <= WS_U, "ws map 2");
static_assert(WS_U + (size_t)T * DM * 2 <= WS_H && WS_H + (size_t)T * DFF * 2 <= WS_PRE && WS_PRE + (size_t)T * DM * 4 <= WS_X1 && WS_X1 + (size_t)T * DM * 4 <= WS_HP && WS_HP + (size_t)T * INP_PAD * 4 <= WS_CQN, "ws map 3");
static_assert(WS_CQN + (size_t)T * QLORA * 2 <= WS_CKV && WS_CKV + (size_t)TKV * KVLORA * 2 <= WS_KR && WS_KR + (size_t)TKV * DROPE * 2 <= WS_POOLED && WS_POOLED + (size_t)T * POOLW * 2 <= WS_Q && WS_Q + (size_t)T * DQ * 2 <= WS_KV && WS_KV + (size_t)TKV * DKV * 2 <= WS_MIXIN && WS_MIXIN + (size_t)T * DM * 2 <= WS_END, "ws map 4");
static_assert(WS_MODS + (size_t)3 * NMOD * 4 <= CTL_ZERO_BYTES, "mods inside the memset region");
constexpr size_t WS_WIN8 = WS_WIN, WS_WINB = WS_WIN + 12 * MiB;
constexpr int NIN8 = QLORA + POOLW, NINB = 768, NINB_REAL = KVLORA + DROPE;
constexpr int CW_BAR = 4096;
constexpr int RING_OFF = 0, RING_BYTES = 131072;
constexpr int LDSCTL_OFF = RING_BYTES, MISC_OFF = LDSCTL_OFF + 320;
constexpr int LDS_BYTES = 147456;
constexpr int NWAVES = 8;

__device__ __forceinline__ float wave_sum(float v) {
#pragma unroll
    for (int o = 1; o < 64; o <<= 1) v += __shfl_xor(v, o);
    return v;
}
__device__ __forceinline__ float hsum4(f32x4 v) { return (v.x + v.y) + (v.z + v.w); }
__device__ __forceinline__ float hsq4(f32x4 v) { return (v.x * v.x + v.y * v.y) + (v.z * v.z + v.w * v.w); }
__device__ __forceinline__ void st_bf16x4(bf16* p, f32x4 v) { v2u w; w.x = pk2(v.x, v.y); w.y = pk2(v.z, v.w); *(GAS v2u*)p = w; }
__device__ __forceinline__ void st_fp8x4(unsigned char* p, f32x4 v) { *(GAS unsigned*)p = pg8::pk4_fp8(v.x, v.y, v.z, v.w); }

__device__ __forceinline__ void p0_ada(const float* c_ctx, const float* c, const float* w_ada, const float* b_ada, float* mods, LAS unsigned char* lds, int tid, int wave, int lane, int bid, int G) {
    LAS float* sc = (LAS float*)lds;
    LAS float* red = (LAS float*)(lds + 49152);
    for (int i = tid; i < 3 * DM; i += NWAVES * 64) { const int s = i >> 12, k = i & (DM - 1); const float v = (s == 0) ? c_ctx[k] : c[(s - 1) * DM + k]; sc[i] = v / (1.0f + __expf(-v)); }
    __syncthreads();
    constexpr int NKC = DM / 256, NCC = NMOD / 256;
    for (int it = bid; it < NKC * NCC; it += G) {
        const int kc = it / NCC, cc = it % NCC, k0 = kc * 256 + wave * 32;
        const float* wp = w_ada + (size_t)k0 * NMOD + cc * 256 + lane * 4;
        f32x4 a0 = {0.f, 0.f, 0.f, 0.f}, a1 = a0, a2 = a0;
#pragma unroll 16
        for (int i = 0; i < 32; ++i) { const f32x4 w = __builtin_nontemporal_load((const GAS f32x4*)(wp + (size_t)i * NMOD)); const float s0 = sc[k0 + i], s1 = sc[DM + k0 + i], s2 = sc[2 * DM + k0 + i]; a0 += w * s0; a1 += w * s1; a2 += w * s2; }
        *(LAS f32x4*)(red + (wave * 3 + 0) * 256 + lane * 4) = a0; *(LAS f32x4*)(red + (wave * 3 + 1) * 256 + lane * 4) = a1; *(LAS f32x4*)(red + (wave * 3 + 2) * 256 + lane * 4) = a2;
        __syncthreads();
        for (int o = tid; o < 768; o += NWAVES * 64) { const int s = o >> 8, col = o & 255; float sum = 0.f;
#pragma unroll
            for (int w = 0; w < NWAVES; ++w) sum += red[(w * 3 + s) * 256 + col];
            if (kc == 0) sum += b_ada[cc * 256 + col];
            atomicAdd(mods + (size_t)s * NMOD + cc * 256 + col, sum); }
        __syncthreads();
    }
}
__device__ __forceinline__ void tile_load32(float (&r_)[32], const float* W, int N, int k0, int n0, int lane) {
    const char* sb_ = (const char*)(W + (size_t)k0 * N + n0); const unsigned vb_ = (unsigned)((lane >> 5) * N + (lane & 31)) * 4u; const size_t st_ = (size_t)N * 8;
#pragma unroll
    for (int i = 0; i < 32; ++i) { const char* p_ = sb_ + (size_t)i * st_; asm volatile("global_load_dword %0, %1, %2 nt" : "=v"(r_[i]) : "v"(vb_), "s"(p_)); }
    asm volatile("s_waitcnt vmcnt(0)" : "+v"(r_[0]), "+v"(r_[1]), "+v"(r_[2]), "+v"(r_[3]), "+v"(r_[4]), "+v"(r_[5]), "+v"(r_[6]), "+v"(r_[7]) :: "memory");
    asm volatile("" : "+v"(r_[8]), "+v"(r_[9]), "+v"(r_[10]), "+v"(r_[11]), "+v"(r_[12]), "+v"(r_[13]), "+v"(r_[14]), "+v"(r_[15]));
    asm volatile("" : "+v"(r_[16]), "+v"(r_[17]), "+v"(r_[18]), "+v"(r_[19]), "+v"(r_[20]), "+v"(r_[21]), "+v"(r_[22]), "+v"(r_[23]));
    asm volatile("" : "+v"(r_[24]), "+v"(r_[25]), "+v"(r_[26]), "+v"(r_[27]), "+v"(r_[28]), "+v"(r_[29]), "+v"(r_[30]), "+v"(r_[31]));
}
__device__ __forceinline__ void transpose_item(const float* W, int N, int k0, int n0, bf16* WTrow0, int Kld, LAS float* scr, int lane) {
    { float r_[32]; tile_load32(r_, W, N, k0, n0, lane);
#pragma unroll
    for (int i = 0; i < 32; ++i) scr[(2 * i + (lane >> 5)) * 33 + (lane & 31)] = r_[i]; }
    LDS_WAIT(); asm volatile("" ::: "memory");
    const int c = lane & 7;
#pragma unroll
    for (int j = 0; j < 4; ++j) { const int n = (lane >> 3) + 8 * j; const LAS float* s = scr + (8 * c) * 33 + n;
        v4u o; o.x = pk2(s[0 * 33], s[1 * 33]); o.y = pk2(s[2 * 33], s[3 * 33]); o.z = pk2(s[4 * 33], s[5 * 33]); o.w = pk2(s[6 * 33], s[7 * 33]);
        *(GAS v4u*)(WTrow0 + (size_t)n * Kld + k0 + 8 * c) = o; }
    LDS_WAIT(); asm volatile("" ::: "memory");
}
__device__ __forceinline__ void transpose_item_f8(const float* W, int N, int k0, int n0, unsigned char* WTrow0, int Kld, float scale, LAS float* scr, int lane) {
    { float r_[32]; tile_load32(r_, W, N, k0, n0, lane);
#pragma unroll
    for (int i = 0; i < 32; ++i) scr[(2 * i + (lane >> 5)) * 33 + (lane & 31)] = r_[i]; }
    LDS_WAIT(); asm volatile("" ::: "memory");
    const int c = lane & 3;
    const float ds = 1.0f / scale;
#pragma unroll
    for (int j = 0; j < 2; ++j) { const int n = (lane >> 2) + 16 * j; const LAS float* s = scr + (16 * c) * 33 + n;
        v4u o; o.x = pg8::pk4_fp8_sc(s[0 * 33], s[1 * 33], s[2 * 33], s[3 * 33], ds); o.y = pg8::pk4_fp8_sc(s[4 * 33], s[5 * 33], s[6 * 33], s[7 * 33], ds);
        o.z = pg8::pk4_fp8_sc(s[8 * 33], s[9 * 33], s[10 * 33], s[11 * 33], ds); o.w = pg8::pk4_fp8_sc(s[12 * 33], s[13 * 33], s[14 * 33], s[15 * 33], ds);
        *(GAS v4u*)(WTrow0 + (size_t)n * Kld + k0 + 16 * c) = o; }
    LDS_WAIT(); asm volatile("" ::: "memory");
}
__device__ __forceinline__ void tile_fin_f8(const float (&r_)[32], int k0, unsigned char* WTrow0, int Kld, float ds, LAS float* scr, int lane) {
#pragma unroll
    for (int i = 0; i < 32; ++i) scr[(2 * i + (lane >> 5)) * 33 + (lane & 31)] = r_[i];
    LDS_WAIT(); asm volatile("" ::: "memory");
    const int c = lane & 3;
#pragma unroll
    for (int j = 0; j < 2; ++j) { const int n = (lane >> 2) + 16 * j; const LAS float* s = scr + (16 * c) * 33 + n;
        v4u o; o.x = pg8::pk4_fp8_sc(s[0 * 33], s[1 * 33], s[2 * 33], s[3 * 33], ds); o.y = pg8::pk4_fp8_sc(s[4 * 33], s[5 * 33], s[6 * 33], s[7 * 33], ds);
        o.z = pg8::pk4_fp8_sc(s[8 * 33], s[9 * 33], s[10 * 33], s[11 * 33], ds); o.w = pg8::pk4_fp8_sc(s[12 * 33], s[13 * 33], s[14 * 33], s[15 * 33], ds);
        *(GAS v4u*)(WTrow0 + (size_t)n * Kld + k0 + 16 * c) = o; }
    LDS_WAIT(); asm volatile("" ::: "memory");
}
__device__ __forceinline__ void transpose_item_f8_x2(const float* W, int N, int k0, int n0, unsigned char* WTrow0, int Kld, float scale, LAS float* scr, int lane) {
    float ra[32], rb[32];
    const char* sb_ = (const char*)(W + (size_t)k0 * N + n0); const unsigned vb_ = (unsigned)((lane >> 5) * N + (lane & 31)) * 4u; const size_t st_ = (size_t)N * 8;
#pragma unroll
    for (int i = 0; i < 32; ++i) { const char* p_ = sb_ + (size_t)i * st_; asm volatile("global_load_dword %0, %1, %2 nt" : "=v"(ra[i]) : "v"(vb_), "s"(p_)); asm volatile("global_load_dword %0, %1, %2 offset:128 nt" : "=v"(rb[i]) : "v"(vb_), "s"(p_)); }
    asm volatile("s_waitcnt vmcnt(0)" : "+v"(ra[0]), "+v"(ra[1]), "+v"(ra[2]), "+v"(ra[3]), "+v"(ra[4]), "+v"(ra[5]), "+v"(ra[6]), "+v"(ra[7]) :: "memory");
    asm volatile("" : "+v"(ra[8]), "+v"(ra[9]), "+v"(ra[10]), "+v"(ra[11]), "+v"(ra[12]), "+v"(ra[13]), "+v"(ra[14]), "+v"(ra[15]));
    asm volatile("" : "+v"(ra[16]), "+v"(ra[17]), "+v"(ra[18]), "+v"(ra[19]), "+v"(ra[20]), "+v"(ra[21]), "+v"(ra[22]), "+v"(ra[23]));
    asm volatile("" : "+v"(ra[24]), "+v"(ra[25]), "+v"(ra[26]), "+v"(ra[27]), "+v"(ra[28]), "+v"(ra[29]), "+v"(ra[30]), "+v"(ra[31]));
    asm volatile("" : "+v"(rb[0]), "+v"(rb[1]), "+v"(rb[2]), "+v"(rb[3]), "+v"(rb[4]), "+v"(rb[5]), "+v"(rb[6]), "+v"(rb[7]));
    asm volatile("" : "+v"(rb[8]), "+v"(rb[9]), "+v"(rb[10]), "+v"(rb[11]), "+v"(rb[12]), "+v"(rb[13]), "+v"(rb[14]), "+v"(rb[15]));
    asm volatile("" : "+v"(rb[16]), "+v"(rb[17]), "+v"(rb[18]), "+v"(rb[19]), "+v"(rb[20]), "+v"(rb[21]), "+v"(rb[22]), "+v"(rb[23]));
    asm volatile("" : "+v"(rb[24]), "+v"(rb[25]), "+v"(rb[26]), "+v"(rb[27]), "+v"(rb[28]), "+v"(rb[29]), "+v"(rb[30]), "+v"(rb[31]));
    const float ds = 1.0f / scale;
    tile_fin_f8(ra, k0, WTrow0, Kld, ds, scr, lane);
    tile_fin_f8(rb, k0, WTrow0 + (size_t)32 * Kld, Kld, ds, scr, lane);
}
__device__ const double ROPE_INVF[16] = {1.0, 0.5623413251903491, 0.31622776601683794, 0.17782794100389228, 0.1, 0.05623413251903491, 0.031622776601683794, 0.017782794100389228,
                                          0.01, 0.005623413251903491, 0.0031622776601683794, 0.0017782794100389228, 0.001, 0.0005623413251903491, 0.00031622776601683794, 0.00017782794100389228};
__device__ __forceinline__ void sincos_small(double x, double& s, double& c) {
    const double k = __builtin_rint(x * 0.6366197723675814);
    double r = __builtin_fma(-k, 1.5707963267948966, x); r = __builtin_fma(-k, 6.123233995736766e-17, r);
    const int q = ((int)k) & 3; const double r2 = r * r;
    const double sp = r * (1.0 + r2 * (-1.0 / 6 + r2 * (1.0 / 120 + r2 * (-1.0 / 5040 + r2 * (1.0 / 362880 + r2 * (-1.0 / 39916800 + r2 * (1.0 / 6227020800.0)))))));
    const double cp = 1.0 + r2 * (-0.5 + r2 * (1.0 / 24 + r2 * (-1.0 / 720 + r2 * (1.0 / 40320 + r2 * (-1.0 / 3628800 + r2 * (1.0 / 479001600.0 + r2 * (-1.0 / 87178291200.0)))))));
    s = (q == 0) ? sp : (q == 1) ? cp : (q == 2) ? -sp : -cp;
    c = (q == 0) ? cp : (q == 1) ? -sp : (q == 2) ? -cp : sp;
}
struct WPtrs { const float *w_in, *w_uq, *w_ukv, *w_pool, *w_out, *w_gate, *w_up, *w_down; };
__device__ __forceinline__ void p0_convert(const WPtrs& P, unsigned char* ws, LAS unsigned char* lds, int tid, int wave, int lane, int bid, int G) {
    LAS float* scr = (LAS float*)(lds + wave * 16384);
    const int gw = bid * NWAVES + wave, NGW = G * NWAVES;
    constexpr int I_GU = (DM / 64) * (DFF / 32), I_D = (DFF / 64) * (DM / 32), I_IN = (DM / 64) * (INP / 32), I_UQ = (QLORA / 64) * (DQ / 32), I_UKV = (KVLORA / 64) * (DKV / 32), I_P1 = (512 / 64) * (512 / 32), I_OUT = (DM / 64) * (DM / 32);
    constexpr int NITEMS = 4 * I_GU + I_IN + I_UQ + I_UKV + 4 * I_P1 + I_OUT;
    for (int it = gw; it < NITEMS; it += NGW) {
        int r = it;
        if (r < 4 * I_GU) { const int which = r / I_GU; r -= which * I_GU; const int l = which >> 1, up = which & 1; const float* W = (up ? P.w_up : P.w_gate) + (size_t)l * DM * DFF;
            constexpr int nb2 = DFF / 64; const int g8 = r >> 3, w8 = r & 7, kb = 4 * (g8 / nb2) + (w8 >> 1), n0 = (2 * (g8 % nb2) + (w8 & 1)) * 32;
            unsigned char* WT = (ws + (l ? WS_WGU1 : WS_WGU0))
                 + (size_t)((n0 >> 7) * 256 + (n0 & 127) + up * 128) * DM;
            transpose_item_f8(W, DFF, kb * 64, n0, WT, DM, WGU_SCALE, scr, lane); continue; }
        r -= 4 * I_GU;
        if (r < I_IN) { constexpr int nblk = INP / 32; const int kb = r / nblk, n0 = (r % nblk) * 32;
            if (n0 >= QLORA && n0 < QLORA + NINB_REAL) transpose_item(P.w_in, INP, kb * 64, n0, (bf16*)(ws + WS_WINB) + (size_t)(n0 - QLORA) * DM, DM, scr, lane);
            else transpose_item_f8(P.w_in, INP, kb * 64, n0, (ws + WS_WIN8) + (size_t)(n0 < QLORA ? n0 : n0 - NINB_REAL) * DM, DM, WIN_SCALE, scr, lane);
            continue; }
        r -= I_IN;
        if (r < I_UQ) { constexpr int nblk = DQ / 32; const int kb = r / nblk, n0 = (r % nblk) * 32; transpose_item_f8(P.w_uq, DQ, kb * 64, n0, (ws + WS_WUQ) + (size_t)n0 * QLORA, QLORA, WUQ_SCALE, scr, lane); continue; }
        r -= I_UQ;
        if (r < I_UKV) { constexpr int nblk = DKV / 32; const int kb = r / nblk, n0 = (r % nblk) * 32; transpose_item_f8(P.w_ukv, DKV, kb * 64, n0, (ws + WS_WUKV) + (size_t)n0 * KVLORA, KVLORA, WUKV_SCALE, scr, lane); continue; }
        r -= I_UKV;
        if (r < 4 * I_P1) { const int gi = r / I_P1; r -= gi * I_P1; constexpr int nblk = 512 / 32; const int kb = r / nblk, n0 = (r % nblk) * 32;
            transpose_item_f8(P.w_pool + (size_t)gi * 512 * 512, 512, kb * 64, n0, (ws + WS_WPOOL) + (size_t)(gi * 512 + n0) * 512, 512, WPOOL_SCALE, scr, lane); continue; }
        r -= 4 * I_P1;
        { constexpr int nblk = DM / 32; const int kb = r / nblk, n0 = (r % nblk) * 32; transpose_item_f8(P.w_out, DM, kb * 64, n0, (ws + WS_WOUT) + (size_t)n0 * DM, DM, WOUT_SCALE, scr, lane); }
    }
    { GAS v4u* z = (GAS v4u*)((bf16*)(ws + WS_WINB) + (size_t)NINB_REAL * DM); const int n16 = (NINB - NINB_REAL) * DM * 2 / 16;
        for (int i = bid * (NWAVES * 64) + tid; i < n16; i += G * NWAVES * 64) z[i] = (v4u){0u, 0u, 0u, 0u}; }
    { float* tab = (float*)(ws + WS_ROPE);
        for (int i = bid * (NWAVES * 64) + tid; i < S_LAT * 32; i += G * NWAVES * 64) { const int pos = i >> 5, f = i & 31; const double id = (f < 16) ? (double)(pos >> 6) : (double)(pos & 63);
            double s, c; sincos_small(id * ROPE_INVF[f & 15], s, c); tab[i] = (float)c; tab[S_LAT * 32 + i] = (float)s; } }
}

__device__ __forceinline__ void convert_wdown(const float* w_down_l, unsigned char* WD, LAS unsigned char* lds, int wave, int lane, int rank, int nidle) {
    LAS float* scr = (LAS float*)(lds + wave * 16384);
    constexpr int I_D = (DFF / 64) * (DM / 64), nb2 = DM / 128;
    for (int it = rank * NWAVES + wave; it < I_D; it += nidle * NWAVES) { const int g8 = it >> 3, w8 = it & 7, kb = 4 * (g8 / nb2) + (w8 >> 1), n0 = (2 * (g8 % nb2) + (w8 & 1)) * 64;
        transpose_item_f8_x2(w_down_l, DM, kb * 64, n0, WD + (size_t)n0 * DFF, DFF, WD_SCALE, scr, lane); }
}

__device__ __forceinline__ const float* x_row(const float* x_prompt, const float* x_sample, int m) { return m < T_CTX ? x_prompt + (size_t)m * DM : x_sample + (size_t)(m - T_CTX) * DM; }
__device__ __forceinline__ int mset_of_row(int m) { return m < T_CTX ? 0 : 1 + ((m - T_CTX) >> 10); }
__device__ __forceinline__ f32x4 bf4_to_f32(v2u w) { f32x4 r; r.x = __uint_as_float(w.x << 16); r.y = __uint_as_float(w.x & 0xffff0000u); r.z = __uint_as_float(w.y << 16); r.w = __uint_as_float(w.y & 0xffff0000u); return r; }
struct RowRegs { f32x4 r[16]; v2u d[16]; };
constexpr int LN_LDS_GAMMA = 0, LN_LDS_BETA = 16384, LN_LDS_MOD = 32768;
template <bool AFFINE> __device__ __forceinline__ void ln_load(RowRegs& R, const float* res, const bf16* d, int lane) {
    const GAS f32x4* xr = (const GAS f32x4*)res + lane;
#pragma unroll
    for (int j = 0; j < 16; ++j) R.r[j] = __builtin_nontemporal_load(&xr[64 * j]);
    if constexpr (AFFINE) { const GAS v2u* dr = (const GAS v2u*)d + lane;
#pragma unroll
        for (int j = 0; j < 16; ++j) R.d[j] = __builtin_nontemporal_load(&dr[64 * j]); }
    asm volatile("" ::: "memory");
}
template <bool AFFINE> __device__ __forceinline__ float ln_combine(f32x4 (&cur)[16], const RowRegs& R, const bf16* d2, int lane) {
    float s = 0.f;
    if constexpr (AFFINE) {
        if (d2) { const GAS v2u* d2r = (const GAS v2u*)d2 + lane;
#pragma unroll
            for (int j = 0; j < 16; ++j) { cur[j] = R.r[j] * DN_ALPHA + (bf4_to_f32(R.d[j]) + bf4_to_f32(d2r[64 * j])); s += hsum4(cur[j]); } }
        else {
#pragma unroll
            for (int j = 0; j < 16; ++j) { cur[j] = R.r[j] * DN_ALPHA + bf4_to_f32(R.d[j]); s += hsum4(cur[j]); } }
    } else {
#pragma unroll
        for (int j = 0; j < 16; ++j) { cur[j] = R.r[j]; s += hsum4(cur[j]); }
    }
    asm volatile("" ::: "memory");
    return s;
}
template <bool AFFINE, bool MOD, int OUTM  >
__device__ __forceinline__ void ln_finish(f32x4 (&v)[16], float s, LAS unsigned char* lds, int mset, float* xout, bf16* uout, unsigned char* uout8, int lane) {
    float mean = wave_sum(s) * (1.f / DM), s2 = 0.f;
#pragma unroll
    for (int j = 0; j < 16; ++j) { v[j] = v[j] - mean; s2 += hsq4(v[j]); }
    float rstd = 1.0f / sqrtf(wave_sum(s2) * (1.f / DM) + LN_EPS);
    if constexpr (AFFINE) {
        const LAS f32x4* g4 = (const LAS f32x4*)(lds + LN_LDS_GAMMA) + lane; const LAS f32x4* b4 = (const LAS f32x4*)(lds + LN_LDS_BETA) + lane; GAS f32x4* xo = (GAS f32x4*)xout + lane;
        s = 0.f;
#pragma unroll
        for (int j = 0; j < 16; ++j) { v[j] = v[j] * rstd * g4[64 * j] + b4[64 * j]; __builtin_nontemporal_store(v[j], &xo[64 * j]); s += hsum4(v[j]); if ((j & 3) == 3) asm volatile("" ::: "memory"); }
        if constexpr (MOD) {
            mean = wave_sum(s) * (1.f / DM); s2 = 0.f;
#pragma unroll
            for (int j = 0; j < 16; ++j) { v[j] = v[j] - mean; s2 += hsq4(v[j]); }
            rstd = 1.0f / sqrtf(wave_sum(s2) * (1.f / DM) + LN_EPS);
        }
    }
    if constexpr (MOD) {
        const LAS f32x4* sh4 = (const LAS f32x4*)(lds + LN_LDS_MOD + mset * 32768) + lane; const LAS f32x4* sc4 = (const LAS f32x4*)(lds + LN_LDS_MOD + mset * 32768 + 16384) + lane;
#pragma unroll
        for (int j = 0; j < 16; ++j) { const f32x4 o = v[j] * rstd * (sc4[64 * j] + 1.0f) + sh4[64 * j];
            if constexpr (OUTM >= 1) *((GAS unsigned*)uout8 + lane + 64 * j) = pg8::pk4_fp8(o.x, o.y, o.z, o.w);
            if constexpr (OUTM != 1) st_bf16x4(uout + 4 * (lane + 64 * j), o);
            if ((j & 3) == 3) asm volatile("" ::: "memory"); }
    }
}
template <bool AFFINE, bool MOD, int OUTM>
__device__ __forceinline__ void ln_phase(const float* resA, const float* resB, const bf16* d, const bf16* d2, const float* gamma, const float* beta, const float* mods, int ish, int isc,
                                         float* xoutA, float* xoutB, bf16* uout, unsigned char* uout8, LAS unsigned char* lds, int tid, int lane, int gw, int NGW) {
    for (int c = tid; c < 8192; c += NWAVES * 64) { const int reg = c >> 10, o = (c & 1023) * 4; const float* src;
        if (reg == 0) src = gamma; else if (reg == 1) src = beta; else { const int sset = (reg - 2) >> 1; src = mods + (size_t)sset * NMOD + (size_t)(((reg - 2) & 1) ? isc : ish) * DM; }
        if ((reg >= 2) ? MOD : AFFINE) *(LAS f32x4*)(lds + c * 16) = *(const GAS f32x4*)(src + o); }
    LDS_WAIT(); __syncthreads();
    RowRegs N; f32x4 cur[16];
    int m = gw;
    if (m < T) ln_load<AFFINE>(N, m < T_CTX ? resA + (size_t)m * DM : resB + (size_t)(m - T_CTX) * DM, d + (size_t)m * DM, lane);
    for (; m < T; m += NGW) {
        const float s = ln_combine<AFFINE>(cur, N, (AFFINE && m >= T_CTX) ? d2 + (size_t)(m - T_CTX) * DM : (const bf16*)nullptr, lane);
        const int mn = m + NGW;
        if (mn < T) ln_load<AFFINE>(N, mn < T_CTX ? resA + (size_t)mn * DM : resB + (size_t)(mn - T_CTX) * DM, d + (size_t)mn * DM, lane);
        ln_finish<AFFINE, MOD, OUTM>(cur, s, lds, mset_of_row(m), AFFINE ? (m < T_CTX ? xoutA + (size_t)m * DM : xoutB + (size_t)(m - T_CTX) * DM) : (float*)nullptr, uout + (size_t)m * DM, uout8 + (size_t)m * DM, lane);
    }
    __syncthreads();
}
__device__ __forceinline__ void p6_row(int m, const bf16* __restrict__ HQP, const float* __restrict__ HK0, const float* __restrict__ HK1, const f32x4 (&gq)[4], const f32x4 (&gkv)[2], const float* __restrict__ rope_tab,
                                       float* __restrict__ out, unsigned char* __restrict__ CQN, unsigned char* __restrict__ CKV, bf16* __restrict__ KR, unsigned char* __restrict__ POOLED, int lane) {
    const bf16* hq = HQP + (size_t)m * NIN8; const float* k0p = HK0 + (size_t)m * NINB; const float* k1p = HK1 + (size_t)m * NINB;
    int t, len; if (m < T_CTX) { t = m & (S_CTX - 1); len = S_CTX; } else { t = (m - T_CTX) & (S_LAT - 1); len = S_LAT; }
    const bf16* base = HQP + (size_t)(m - t) * NIN8 + QLORA;
    v2u cq[4]; f32x4 ka[2], kb[2];
#pragma unroll
    for (int j = 0; j < 4; ++j) cq[j] = *(const GAS v2u*)(hq + 4 * (lane + 64 * j));
#pragma unroll
    for (int j = 0; j < 2; ++j) { ka[j] = *(const GAS f32x4*)(k0p + 4 * (lane + 64 * j)); kb[j] = *(const GAS f32x4*)(k1p + 4 * (lane + 64 * j)); }
    float kr = k0p[KVLORA + lane] + k1p[KVLORA + lane];
    v4u w[30], xc[4];
    {   int q = 0;
#pragma unroll
        for (int gi = 0; gi < 4; ++gi) { const int half = 1 << gi;
#pragma unroll
            for (int dr = -half; dr < half; ++dr, ++q) { const int r = t + dr; const bool ok = (r >= 0) && (r < len); const int rc = ok ? r : t;
                w[q] = *(const GAS v4u*)(base + (size_t)rc * NIN8 + gi * 512 + 8 * lane); }
            xc[gi] = *(const GAS v4u*)(base + (size_t)t * NIN8 + gi * 512 + 8 * lane); } }
    {   f32x4 v[4]; float s = 0.f;
#pragma unroll
        for (int j = 0; j < 4; ++j) { v[j] = bf4_to_f32(cq[j]); s += hsq4(v[j]); }
        const float rstd = 1.0f / sqrtf(wave_sum(s) * (1.f / QLORA) + RMS_EPS);
#pragma unroll
        for (int j = 0; j < 4; ++j) st_fp8x4(CQN + (size_t)m * QLORA + 4 * (lane + 64 * j), v[j] * rstd * gq[j]); }
    {   f32x4 v[2]; float s = 0.f;
#pragma unroll
        for (int j = 0; j < 2; ++j) { v[j] = ka[j] + kb[j]; s += hsq4(v[j]); }
        const float rstd = 1.0f / sqrtf(wave_sum(s) * (1.f / KVLORA) + RMS_EPS);
#pragma unroll
        for (int j = 0; j < 2; ++j) { const f32x4 o = v[j] * rstd * gkv[j];
            if (m < T_CTX) *(GAS f32x4*)(out + OUT_CKV + (size_t)m * KVLORA + 4 * (lane + 64 * j)) = o;
            st_fp8x4(CKV + (size_t)m * KVLORA + 4 * (lane + 64 * j), o); } }
    {   float v = kr;
        if (m < T_CTX) out[OUT_KROPE + (size_t)m * DROPE + lane] = v;
        else { const int pos = (m - T_CTX) & (S_LAT - 1), i = lane & 31; const float cs = rope_tab[pos * 32 + i], sn = rope_tab[S_LAT * 32 + pos * 32 + i]; const float other = __shfl_xor(v, 32);
            v = (lane < 32) ? v * cs - other * sn : other * sn + v * cs; }
        KR[(size_t)m * DROPE + lane] = (bf16)f2bf(v); }
    {   int q = 0;
#pragma unroll
        for (int gi = 0; gi < 4; ++gi) { const int half = 1 << gi; const int lo = (t - half) > 0 ? (t - half) : 0, hi = (t + half) < len ? (t + half) : len;
            f32x4 a0 = {0.f, 0.f, 0.f, 0.f}, a1 = a0;
#pragma unroll
            for (int dr = -half; dr < half; ++dr, ++q) { const int r = t + dr; const float wgt = ((r >= 0) && (r < len)) ? 1.0f : 0.0f;
                a0 += bf4_to_f32((v2u){w[q].x, w[q].y}) * wgt; a1 += bf4_to_f32((v2u){w[q].z, w[q].w}) * wgt; }
            const float inv = 1.0f / (float)(hi - lo);
            const f32x4 o0 = a0 * inv - bf4_to_f32((v2u){xc[gi].x, xc[gi].y}), o1 = a1 * inv - bf4_to_f32((v2u){xc[gi].z, xc[gi].w});
            v2u ow; ow.x = pg8::pk4_fp8(o0.x, o0.y, o0.z, o0.w); ow.y = pg8::pk4_fp8(o1.x, o1.y, o1.z, o1.w);
            *(GAS v2u*)(POOLED + (size_t)m * POOLW + gi * 512 + 8 * lane) = ow; } }
}

namespace att {
using f32x16 = __attribute__((ext_vector_type(16))) float;
using s16x4  = __attribute__((ext_vector_type(4))) short;
using u32x4  = __attribute__((ext_vector_type(4))) unsigned;
typedef short v4i16_t __attribute__((ext_vector_type(4)));
typedef LAS const char* lds_cptr;
constexpr float SCALE = 0.07216878364870322f;
constexpr float THR = 8.f;
constexpr int SHM_V = 64 * 128 * 2, SHM_KN = 64 * 128 * 2, SHM_KR = 64 * 64 * 2;
constexpr int OFF_V = 0, OFF_KN = 2 * SHM_V, OFF_KR = OFF_KN + 2 * SHM_KN, OFF_WS = OFF_KR + 2 * SHM_KR, ATT_LDS_BYTES = OFF_WS + NWAVES * 64 * 4;
static_assert(ATT_LDS_BYTES <= RING_BYTES, "attention LDS");
#define KSWZ(row, colB) ((row) * 256 + ((colB) ^ (((row) & 7) << 4)))
#define RSWZ(row, colB) ((row) * 128 + ((colB) ^ (((row) & 7) << 4)))
#define SBAR() __builtin_amdgcn_sched_barrier(0)
__device__ __forceinline__ int crow(int r, int hi) { return (r & 3) + 8 * (r >> 2) + 4 * hi; }
__device__ __forceinline__ unsigned cvtpk(float lo, float hi) { unsigned r; asm volatile("v_cvt_pk_bf16_f32 %0, %1, %2" : "=v"(r) : "v"(lo), "v"(hi)); return r; }
__device__ __forceinline__ void partialSM(f32x16& p0, f32x16& p1, float& m_reg, float& mn, float& alpha) {
  constexpr float C = SCALE * 1.4426950408889634f;
  float pmax = p0[0];
#pragma unroll
  for (int r = 1; r < 16; ++r) pmax = fmaxf(pmax, p0[r]);
#pragma unroll
  for (int r = 0; r < 16; ++r) pmax = fmaxf(pmax, p1[r]);
  { auto rr = __builtin_amdgcn_permlane32_swap(__float_as_uint(pmax), __float_as_uint(pmax), false, false);
    pmax = fmaxf(__uint_as_float(rr[0]), __uint_as_float(rr[1])); }
  if (__builtin_expect(__all(pmax - m_reg <= THR / SCALE), 1)) { mn = m_reg; alpha = 1.f; }
  else { mn = fmaxf(m_reg, pmax); alpha = __builtin_amdgcn_exp2f((m_reg - mn) * C); m_reg = mn; }
  const float mnC = -mn * C;
#pragma unroll
  for (int r = 0; r < 16; ++r) p0[r] = fmaf(p0[r], C, mnC);
#pragma unroll
  for (int r = 0; r < 16; ++r) p1[r] = fmaf(p1[r], C, mnC);
#pragma unroll
  for (int r = 0; r < 16; ++r) p0[r] = __builtin_amdgcn_exp2f(p0[r]);
}
__device__ __forceinline__ void finishSM(f32x16& p0, f32x16& p1, float alpha, float& l_reg, bf16x8& pa0, bf16x8& pa1, bf16x8& pa2, bf16x8& pa3) {
#pragma unroll
  for (int r = 0; r < 16; ++r) p1[r] = __builtin_amdgcn_exp2f(p1[r]);
  float ps = 0;
#pragma unroll
  for (int r = 0; r < 16; ++r) ps += p0[r];
#pragma unroll
  for (int r = 0; r < 16; ++r) ps += p1[r];
  { auto rr = __builtin_amdgcn_permlane32_swap(__float_as_uint(ps), __float_as_uint(ps), false, false);
    ps = __uint_as_float(rr[0]) + __uint_as_float(rr[1]); }
  l_reg = l_reg * alpha + ps;
#define PK4(P, BASE, OUT) do { unsigned a0 = cvtpk(P[BASE + 0], P[BASE + 1]), a1 = cvtpk(P[BASE + 2], P[BASE + 3]);   \
    unsigned b0 = cvtpk(P[BASE + 4], P[BASE + 5]), b1 = cvtpk(P[BASE + 6], P[BASE + 7]);                              \
    auto r0 = __builtin_amdgcn_permlane32_swap(a0, b0, false, false); auto r1 = __builtin_amdgcn_permlane32_swap(a1, b1, false, false); \
    u32x4 w = {r0[0], r1[0], r0[1], r1[1]}; OUT = __builtin_bit_cast(bf16x8, w); } while (0)
  PK4(p0, 0, pa0); PK4(p0, 8, pa1); PK4(p1, 0, pa2); PK4(p1, 8, pa3);
#undef PK4
}
__device__ __forceinline__ void qkt(f32x16& p0, f32x16& p1, lds_cptr Kn, lds_cptr Kr, const bf16x8 (&qr)[12], int r32, int hi) {
  p0 = f32x16{}; p1 = f32x16{};
#pragma unroll
  for (int d0 = 0; d0 < 8; ++d0) { const int cb = (d0 * 16 + hi * 8) * 2;
    const bf16x8 b0 = *(LAS const bf16x8*)(Kn + KSWZ(r32, cb)); const bf16x8 b1 = *(LAS const bf16x8*)(Kn + KSWZ(32 + r32, cb));
    p0 = __builtin_amdgcn_mfma_f32_32x32x16_bf16(b0, qr[d0], p0, 0, 0, 0);
    p1 = __builtin_amdgcn_mfma_f32_32x32x16_bf16(b1, qr[d0], p1, 0, 0, 0); }
#pragma unroll
  for (int d0 = 0; d0 < 4; ++d0) { const int cb = (d0 * 16 + hi * 8) * 2;
    const bf16x8 b0 = *(LAS const bf16x8*)(Kr + RSWZ(r32, cb)); const bf16x8 b1 = *(LAS const bf16x8*)(Kr + RSWZ(32 + r32, cb));
    p0 = __builtin_amdgcn_mfma_f32_32x32x16_bf16(b0, qr[8 + d0], p0, 0, 0, 0);
    p1 = __builtin_amdgcn_mfma_f32_32x32x16_bf16(b1, qr[8 + d0], p1, 0, 0, 0); }
}
__device__ __forceinline__ int v_st(int k, int c) { const int kk = (k & ~0xC) | ((k & 4) << 1) | ((k & 8) >> 1); return ((kk >> 3) * 4 + (c >> 5)) * 512 + ((kk & 7) * 32 + (c & 31)) * 2; }
__device__ __forceinline__ int v_rd_base(int lane) { return ((lane & 3) << 3) | (((lane >> 2) & 3) << 6) | (((lane >> 4) & 1) << 5) | (((lane >> 5) & 1) << 8); }
constexpr int v_rd_off(int d0, int ks, int half) { return d0 * 512 + ks * 4096 + half * 2048; }
template <int OFF> __device__ __forceinline__ s16x4 tr_read(lds_cptr vb) { return __builtin_bit_cast(s16x4, __builtin_amdgcn_ds_read_tr16_b64_v4i16((LAS v4i16_t*)(vb + OFF))); }
template <int D0> __device__ __forceinline__ void pv_one(f32x16& od, lds_cptr vb, bf16x8 pa0, bf16x8 pa1, bf16x8 pa2, bf16x8 pa3) {
  const s16x4 l0 = tr_read<v_rd_off(D0, 0, 0)>(vb), h0 = tr_read<v_rd_off(D0, 0, 1)>(vb), l1 = tr_read<v_rd_off(D0, 1, 0)>(vb), h1 = tr_read<v_rd_off(D0, 1, 1)>(vb);
  const s16x4 l2 = tr_read<v_rd_off(D0, 2, 0)>(vb), h2 = tr_read<v_rd_off(D0, 2, 1)>(vb), l3 = tr_read<v_rd_off(D0, 3, 0)>(vb), h3 = tr_read<v_rd_off(D0, 3, 1)>(vb);
#define PK(L, H) (bf16x8){L[0], L[1], L[2], L[3], H[0], H[1], H[2], H[3]}
  od = __builtin_amdgcn_mfma_f32_32x32x16_bf16(pa0, PK(l0, h0), od, 0, 0, 0);
  od = __builtin_amdgcn_mfma_f32_32x32x16_bf16(pa1, PK(l1, h1), od, 0, 0, 0);
  od = __builtin_amdgcn_mfma_f32_32x32x16_bf16(pa2, PK(l2, h2), od, 0, 0, 0);
  od = __builtin_amdgcn_mfma_f32_32x32x16_bf16(pa3, PK(l3, h3), od, 0, 0, 0);
#undef PK
}
__device__ __forceinline__ void pv_d0(f32x16* o, lds_cptr vb, bf16x8 pa0, bf16x8 pa1, bf16x8 pa2, bf16x8 pa3) {
  pv_one<0>(o[0], vb, pa0, pa1, pa2, pa3); pv_one<1>(o[1], vb, pa0, pa1, pa2, pa3); pv_one<2>(o[2], vb, pa0, pa1, pa2, pa3); pv_one<3>(o[3], vb, pa0, pa1, pa2, pa3);
}
__device__ __forceinline__ void attn_unit(const bf16* __restrict__ Q, const bf16* __restrict__ KV, const bf16* __restrict__ KR, unsigned char* __restrict__ O, const float* __restrict__ rope_tab,
                                          int qrow0, int h, bool lat, int qpos0, int krow_a, int ntile_a, int krow_b, int NT, LAS unsigned char* lds) {
  const int tid = threadIdx.x, wid = tid >> 6, lane = tid & 63, r32 = lane & 31, hi = lane >> 5;
  lds_cptr V_lds = (lds_cptr)(lds + OFF_V), Kn_lds = (lds_cptr)(lds + OFF_KN), Kr_lds = (lds_cptr)(lds + OFF_KR);
  LAS float* wsf = (LAS float*)(lds + OFF_WS) + wid * 64; LAS float* li_l = wsf; LAS float* al_l = wsf + 32;
  float m_reg = -1e30f, l_reg = 0.f; f32x16 o[4] = {}; bf16x8 qr[12];
  const bf16* Qw = Q + (size_t)(qrow0 + wid * 32 + r32) * DQ + h * DQK + hi * 8;
#pragma unroll
  for (int d0 = 0; d0 < 12; ++d0) qr[d0] = *(const GAS bf16x8*)(Qw + d0 * 16);
  if (lat) {
    const int pos = qpos0 + wid * 32 + r32;
#pragma unroll
    for (int dd = 0; dd < 2; ++dd) {
      const float* ct = rope_tab + pos * 32 + dd * 16 + hi * 8; const float* st = ct + S_LAT * 32;
      const f32x4 c0 = *(const GAS f32x4*)ct, c1 = *(const GAS f32x4*)(ct + 4), s0 = *(const GAS f32x4*)st, s1 = *(const GAS f32x4*)(st + 4);
      bf16x8 x1 = qr[8 + dd], x2 = qr[10 + dd]; float a[8], b[8];
#pragma unroll
      for (int e = 0; e < 8; ++e) { a[e] = __uint_as_float(((unsigned)(unsigned short)x1[e]) << 16); b[e] = __uint_as_float(((unsigned)(unsigned short)x2[e]) << 16); }
      u32x4 w1, w2;
#pragma unroll
      for (int e2 = 0; e2 < 4; ++e2) { const int e = 2 * e2; const float cA = e < 4 ? c0[e] : c1[e - 4], cB = e + 1 < 4 ? c0[e + 1] : c1[e + 1 - 4], sA = e < 4 ? s0[e] : s1[e - 4], sB = e + 1 < 4 ? s0[e + 1] : s1[e + 1 - 4];
        w1[e2] = cvtpk(a[e] * cA - b[e] * sA, a[e + 1] * cB - b[e + 1] * sB); w2[e2] = cvtpk(a[e] * sA + b[e] * cA, a[e + 1] * sB + b[e + 1] * cB); }
      qr[8 + dd] = __builtin_bit_cast(bf16x8, w1); qr[10 + dd] = __builtin_bit_cast(bf16x8, w2);
    }
  }
  const int sr = tid >> 4, sc = (tid & 15) * 8, vst0 = v_st(sr, sc), vst1 = v_st(32 + sr, sc), kst0 = KSWZ(sr, sc * 2), kst1 = KSWZ(32 + sr, sc * 2);
  const int rr = tid >> 3, rc = (tid & 7) * 8, rst = RSWZ(rr, rc * 2);
  lds_cptr vb0 = V_lds + v_rd_base(lane);
  bf16x8 sv0, sv1, sk0, sk1, skr;
  const bf16* KVh = KV + h * (DNOPE + DVH);
#define KROW(j) ((j) < ntile_a ? krow_a + 64 * (j) : krow_b + 64 * ((j) - ntile_a))
#define SLOAD(j) do { const int k0_ = KROW(j); const bf16* p0_ = KVh + (size_t)(k0_ + sr) * DKV + sc; const bf16* p1_ = KVh + (size_t)(k0_ + 32 + sr) * DKV + sc; \
    sk0 = *(const GAS bf16x8*)p0_; sk1 = *(const GAS bf16x8*)p1_; sv0 = *(const GAS bf16x8*)(p0_ + DNOPE); sv1 = *(const GAS bf16x8*)(p1_ + DNOPE); \
    skr = *(const GAS bf16x8*)(KR + (size_t)(k0_ + rr) * DROPE + rc); } while (0)
#define SWRITE(b) do { *(LAS bf16x8*)((LAS char*)(lds + OFF_V) + (b) * SHM_V + vst0) = sv0; *(LAS bf16x8*)((LAS char*)(lds + OFF_V) + (b) * SHM_V + vst1) = sv1; \
    *(LAS bf16x8*)((LAS char*)(lds + OFF_KN) + (b) * SHM_KN + kst0) = sk0; *(LAS bf16x8*)((LAS char*)(lds + OFF_KN) + (b) * SHM_KN + kst1) = sk1; \
    *(LAS bf16x8*)((LAS char*)(lds + OFF_KR) + (b) * SHM_KR + rst) = skr; } while (0)
  SLOAD(0); VM_WAIT(); SWRITE(0);
  if (NT > 1) SLOAD(1);
  LDS_WAIT(); __syncthreads();
  for (int j = 0; j < NT; ++j) {
    const int buf = j & 1;
    f32x16 p0, p1; float mn, alpha; bf16x8 pa0, pa1, pa2, pa3;
    qkt(p0, p1, Kn_lds + buf * SHM_KN, Kr_lds + buf * SHM_KR, qr, r32, hi);
    partialSM(p0, p1, m_reg, mn, alpha);
    if (__any(alpha < 1.f)) { if (hi == 0) al_l[r32] = alpha; LDS_WAIT();
#pragma unroll
      for (int d = 0; d < 4; ++d)
#pragma unroll
        for (int r = 0; r < 16; ++r) o[d][r] *= al_l[crow(r, hi)]; }
    finishSM(p0, p1, alpha, l_reg, pa0, pa1, pa2, pa3);
    pv_d0(o, vb0 + buf * SHM_V, pa0, pa1, pa2, pa3);
    if (j + 1 < NT) { VM_WAIT(); SWRITE(buf ^ 1); if (j + 2 < NT) SLOAD(j + 2); }
    LDS_WAIT(); __syncthreads();
  }
  if (hi == 0) li_l[r32] = l_reg;
  LDS_WAIT();
  float rli[16];
#pragma unroll
  for (int r = 0; r < 16; ++r) rli[r] = __builtin_amdgcn_rcpf(li_l[crow(r, hi)]) * MIX_SCALE;
  unsigned char* Ow = O + (size_t)(qrow0 + wid * 32) * DM + h * DVH;
#pragma unroll
  for (int r = 0; r < 16; ++r) { const int orow = crow(r, hi);
#pragma unroll
    for (int d0 = 0; d0 < 4; ++d0) { const float ov = o[d0][r] * rli[r]; Ow[(size_t)orow * DM + d0 * 32 + r32] = (unsigned char)(__builtin_amdgcn_cvt_pk_fp8_f32(ov, ov, 0, false) & 0xff); } }
#undef KROW
#undef SLOAD
#undef SWRITE
}
#undef KSWZ
#undef RSWZ
#undef SBAR
}

constexpr int N_PHASES = 14;
struct Args { const float* in[21]; float* out; unsigned char* ws; int ph_lo, ph_hi; };
static_assert(sizeof(Args) == 192, "Args has no holes");
__global__ void __launch_bounds__(NWAVES * 64, 2) mk_fwd(Args args) {
    extern __shared__ __attribute__((aligned(16))) unsigned char lds_raw[];
    LAS unsigned char* lds = (LAS unsigned char*)lds_raw;
    volatile LAS unsigned* MISC = (volatile LAS unsigned*)(lds + MISC_OFF);
    const int tid = threadIdx.x, lane = tid & 63, wave = __builtin_amdgcn_readfirstlane(tid >> 6);
    const int G = gridDim.x, bid = blockIdx.x;
    unsigned char* ws = args.ws;
    gu32* ctl = (gu32*)(ws + WS_CTL);
    for (int u = tid; u < (LDS_BYTES - LDSCTL_OFF) / 4; u += NWAVES * 64) ((LAS unsigned*)(lds + LDSCTL_OFF))[u] = 0u;
    __syncthreads();
#if MK_ONE_LAUNCH
    XcdBarrier bar = xcd_barrier_post((unsigned*)(ctl + CW_BAR), MISC + 8);
#define GRID_BAR() xcd_barrier(bar)
#else
    (void)ctl; (void)MISC;
#define GRID_BAR() do { } while (0)
#endif
    const float* x_prompt = args.in[0]; const float* x_sample = args.in[1]; const float* cache_ckv = args.in[2]; const float* cache_krope = args.in[3];
    const float* c_in = args.in[4]; const float* c_ctx = args.in[5]; const float* w_ada = args.in[6]; const float* b_ada = args.in[7];
    const float* g_q = args.in[9]; const float* g_kv = args.in[11]; const float* pool_scale = args.in[14];
    const float* ln_gamma = args.in[19]; const float* ln_beta = args.in[20];
    float* out = args.out;
    float* mods = (float*)(ws + WS_MODS); const float* rope_tab = (const float*)(ws + WS_ROPE);
    bf16* WGU0 = (bf16*)(ws + WS_WGU0); bf16* WGU1 = (bf16*)(ws + WS_WGU1); bf16* WD0 = (bf16*)(ws + WS_WD0); bf16* WD1 = (bf16*)(ws + WS_WD1);
    bf16* WUQ = (bf16*)(ws + WS_WUQ); bf16* WUKV = (bf16*)(ws + WS_WUKV); bf16* WPOOL = (bf16*)(ws + WS_WPOOL); bf16* WOUT = (bf16*)(ws + WS_WOUT);
    bf16* U = (bf16*)(ws + WS_U); unsigned char* U8 = ws + WS_U; unsigned char* H8 = ws + WS_H; bf16* DEL = (bf16*)(ws + WS_PRE); bf16* DEL2 = (bf16*)(ws + WS_HP);     float* X1 = (float*)(ws + WS_X1); bf16* HQP = (bf16*)(ws + WS_HP); float* HK0 = (float*)(ws + WS_HP + 64 * MiB); float* HK1 = (float*)(ws + WS_HP + 96 * MiB);
    unsigned char* CQN = ws + WS_CQN; unsigned char* CKV = ws + WS_CKV; bf16* KR = (bf16*)(ws + WS_KR); unsigned char* POOLED = ws + WS_POOLED;
    bf16* Qb = (bf16*)(ws + WS_Q); bf16* KVb = (bf16*)(ws + WS_KV); unsigned char* MIXIN = ws + WS_MIXIN;
    const int gw = bid * NWAVES + wave, NGW = G * NWAVES;

    const int lo = args.ph_lo, hi = args.ph_hi;
#ifndef PH_MASK
#define PH_MASK 0x3fff
#endif
#define IN(k) (((PH_MASK >> (k)) & 1) && lo <= (k) && (k) < hi)
#define BOTH(k) (IN(k) && IN((k) + 1))
#ifndef PROBE_DUP
#define PROBE_DUP 0
#endif
#define REP(k) for (int rep_ = 0; rep_ < 1 + ((PROBE_DUP >> (k)) & 1); ++rep_)

    if (IN(0)) { REP(0) {
        p0_ada(c_ctx, c_in, w_ada, b_ada, rep_ ? (float*)(ws + WS_PRE) : mods, lds, tid, wave, lane, bid, G);
        __syncthreads();
        WPtrs P; P.w_in = args.in[8]; P.w_uq = args.in[10]; P.w_ukv = args.in[12]; P.w_pool = args.in[13]; P.w_out = args.in[15]; P.w_gate = args.in[16]; P.w_up = args.in[17]; P.w_down = args.in[18];
        p0_convert(P, ws, lds, tid, wave, lane, bid, G);
        }
        if (BOTH(0)) GRID_BAR();
    }
    if (IN(1)) { REP(1) {
        ln_phase<false, true, 1>(x_prompt, x_sample, nullptr, nullptr, nullptr, nullptr, mods, 0, 1, nullptr, nullptr, nullptr, U8, lds, tid, lane, gw, NGW);
        }
        if (BOTH(1)) GRID_BAR();
    }
    if (IN(2)) { REP(2) {
        pg8::Gemm g{(const bf16*)U8, WGU0, T, NGU, DM, DM, 0, 0}; pg8::StaticOrder S; S.init(T, NGU, G, bid, DM / 128);
        pg8::EpiSwigluF8 E{H8, DFF, 1.0f / WGU_SCALE};
        pg8::gemm_phase<pg8::EpiSwigluF8, pg8::StaticOrder, true, true>(lds + RING_OFF, g, S, E);
        { const int nun = (T / 256) * (NGU / 256), rem = nun - (nun / G) * G; if (bid >= rem) convert_wdown(args.in[18], (unsigned char*)WD0, lds, wave, lane, bid - rem, G - rem); }
        }
        if (BOTH(2)) GRID_BAR();
    }
    if (IN(3)) { REP(3) {
        pg8::Gemm g{(const bf16*)H8, WD0, T, DM, DFF, DFF, 0, 0}; pg8::SplitTailOrder S; S.init(T, T_CTX, DM, G, bid, DFF / 128, 44);
        pg8::EpiDelta E{mods + 2 * DM, 0.5f / WD_SCALE, DEL, DEL2};
        pg8::gemm_phase<pg8::EpiDelta, pg8::SplitTailOrder, true, true>(lds + RING_OFF, g, S, E);
        }
        if (BOTH(3)) GRID_BAR();
    }
    if (IN(4)) { REP(4) {
        ln_phase<true, true, 2>(x_prompt, x_sample, DEL, DEL2, ln_gamma + 0 * DM, ln_beta + 0 * DM, mods, 3, 4, X1, X1 + (size_t)T_CTX * DM, U, H8, lds, tid, lane, gw, NGW);
        }
        if (BOTH(4)) GRID_BAR();
    }
    if (IN(5)) { REP(5) {
        { pg8::Gemm g{(const bf16*)H8, (const bf16*)(ws + WS_WIN8), T, NIN8, DM, DM, 0, 0}; pg8::StaticOrder S; S.init(T, NIN8, G, bid, DM / 128);
          pg8::EpiBf16S E{HQP, NIN8, 0, nullptr, 1.0f / WIN_SCALE};
          pg8::gemm_phase<pg8::EpiBf16S, pg8::StaticOrder, true, true>(lds + RING_OFF, g, S, E); }
        { pg8::Gemm g{U, (const bf16*)(ws + WS_WINB), T, NINB, DM, DM, 0, 0};
          const int nfp8 = (T / 256) * (NIN8 / 256), q2 = nfp8 / G, nlight = G - (nfp8 - q2 * G);
          pg8::SplitAllOrder S; S.init(T, NINB, (bid + nlight) % G, 240 - nlight, DM / 128);
          pg8::EpiF32Part E{HK0, NINB, 0, HK1, NINB, NINB_REAL};
          pg8::gemm_phase<pg8::EpiF32Part, pg8::SplitAllOrder, true, false>(lds + RING_OFF, g, S, E); }
        }
        if (BOTH(5)) GRID_BAR();
    }
    if (IN(6)) { REP(6) {
        f32x4 gq[4], gkv[2];
#pragma unroll
        for (int j = 0; j < 4; ++j) gq[j] = *(const GAS f32x4*)(g_q + 4 * (lane + 64 * j));
#pragma unroll
        for (int j = 0; j < 2; ++j) gkv[j] = *(const GAS f32x4*)(g_kv + 4 * (lane + 64 * j));
        for (int m = gw; m < TKV; m += NGW) {
            if (m < T) p6_row(m, HQP, HK0, HK1, gq, gkv, rope_tab, out, CQN, CKV, KR, POOLED, lane);
            else { const int r = m - T;
#pragma unroll
                for (int j = 0; j < 2; ++j) st_fp8x4(CKV + (size_t)m * KVLORA + 4 * (lane + 64 * j), *(const GAS f32x4*)(cache_ckv + (size_t)r * KVLORA + 4 * (lane + 64 * j)));
                KR[(size_t)m * DROPE + lane] = (bf16)f2bf(cache_krope[(size_t)r * DROPE + lane]); }
        }
        }
        if (BOTH(6)) GRID_BAR();
    }
    if (IN(7)) { REP(7) {
        { pg8::Gemm g{(const bf16*)CQN, WUQ, T, DQ, QLORA, QLORA, 0, 0}; pg8::StaticOrder S; S.init(T, DQ, G, bid, QLORA / 128);
          pg8::EpiBf16S E{Qb, DQ, 0, nullptr, 1.0f / WUQ_SCALE};
          pg8::gemm_phase<pg8::EpiBf16S, pg8::StaticOrder, true, true>(lds + RING_OFF, g, S, E); }
        { pg8::Gemm g{(const bf16*)CKV, WUKV, TKV, DKV, KVLORA, KVLORA, 0, 0}; pg8::StaticOrder S; S.init(TKV, DKV, G, (bid + 32) % G, KVLORA / 128);
          pg8::EpiBf16S E{KVb, DKV, 0, nullptr, 1.0f / WUKV_SCALE};
          pg8::gemm_phase<pg8::EpiBf16S, pg8::StaticOrder, true, true>(lds + RING_OFF, g, S, E); }
        { pg8::Gemm g{(const bf16*)POOLED, WPOOL, T, POOLW, 512, POOLW, 1, 512}; pg8::StaticOrder S; S.init(T, POOLW, G, (bid + 128) % G, 512 / 128);
          pg8::EpiF8S E{MIXIN, DM, POOLW, pool_scale, MIX_SCALE / WPOOL_SCALE};
          pg8::gemm_phase<pg8::EpiF8S, pg8::StaticOrder, true, true>(lds + RING_OFF, g, S, E); }
        }
        if (BOTH(7)) GRID_BAR();
    }
    if (IN(8)) { REP(8) {
        for (int vu = bid; vu < 256; vu += G) {
            const bool lat = vu < 128; const int nsub = lat ? 1 : 4;
            for (int i = 0; i < nsub; ++i) {
                int qrow0, h, qpos0, krow_a, nta, krow_b, NT;
                if (lat) { const int b = vu >> 6, qb = vu & 3; h = (vu >> 2) & 15; qrow0 = T_CTX + b * S_LAT + qb * 256; qpos0 = qb * 256; krow_a = T_CTX + b * S_LAT; nta = S_LAT / 64; krow_b = T + b * PAST; NT = (S_LAT + PAST) / 64; }
                else { const int idx = (vu - 128) * 4 + i, b = idx >> 4; h = idx & 15; qrow0 = b * S_CTX; qpos0 = 0; krow_a = b * S_CTX; nta = S_CTX / 64; krow_b = 0; NT = S_CTX / 64; }
                att::attn_unit(Qb, KVb, KR, MIXIN, rope_tab, qrow0, h, lat, qpos0, krow_a, nta, krow_b, NT, lds + RING_OFF);
            }
        }
        }
        if (BOTH(8)) GRID_BAR();
    }
    if (IN(9)) { REP(9) {
        pg8::Gemm g{(const bf16*)MIXIN, WOUT, T, DM, DM, DM, 0, 0}; pg8::SplitTailOrder S; S.init(T, T_CTX, DM, G, bid, DM / 128, 16);
        pg8::EpiDelta E{mods + 5 * DM, 1.0f / (WOUT_SCALE * MIX_SCALE), DEL, DEL2};
        pg8::gemm_phase<pg8::EpiDelta, pg8::SplitTailOrder, true, true>(lds + RING_OFF, g, S, E);
        }
        if (BOTH(9)) GRID_BAR();
    }
    if (IN(10)) { REP(10) {
        ln_phase<true, true, 1>(X1, X1 + (size_t)T_CTX * DM, DEL, DEL2, ln_gamma + 1 * DM, ln_beta + 1 * DM, mods, 6, 7, X1, X1 + (size_t)T_CTX * DM, nullptr, U8, lds, tid, lane, gw, NGW);
        }
        if (BOTH(10)) GRID_BAR();
    }
    if (IN(11)) { REP(11) {
        pg8::Gemm g{(const bf16*)U8, WGU1, T, NGU, DM, DM, 0, 0}; pg8::StaticOrder S; S.init(T, NGU, G, bid, DM / 128);
        pg8::EpiSwigluF8 E{H8, DFF, 1.0f / WGU_SCALE};
        pg8::gemm_phase<pg8::EpiSwigluF8, pg8::StaticOrder, true, true>(lds + RING_OFF, g, S, E);
        { const int nun = (T / 256) * (NGU / 256), rem = nun - (nun / G) * G; if (bid >= rem) convert_wdown(args.in[18] + (size_t)DFF * DM, (unsigned char*)WD1, lds, wave, lane, bid - rem, G - rem); }
        }
        if (BOTH(11)) GRID_BAR();
    }
    if (IN(12)) { REP(12) {
        pg8::Gemm g{(const bf16*)H8, WD1, T, DM, DFF, DFF, 0, 0}; pg8::SplitTailOrder S; S.init(T, T_CTX, DM, G, bid, DFF / 128, 44);
        pg8::EpiDelta E{mods + 8 * DM, 0.5f / WD_SCALE, DEL, DEL2};
        pg8::gemm_phase<pg8::EpiDelta, pg8::SplitTailOrder, true, true>(lds + RING_OFF, g, S, E);
        }
        if (BOTH(12)) GRID_BAR();
    }
    if (IN(13)) { REP(13) {
        ln_phase<true, false, 0>(X1, X1 + (size_t)T_CTX * DM, DEL, DEL2, ln_gamma + 2 * DM, ln_beta + 2 * DM, mods, 0, 0, out, out + (size_t)T_CTX * DM, nullptr, nullptr, lds, tid, lane, gw, NGW); }
    }
#undef IN
#undef BOTH
}

extern "C" void kernel_launch(void* const* d_in, const int* in_sizes, int n_in, void* d_out, int out_size, void* d_ws, size_t ws_size, hipStream_t stream) {
    static int grid = 0;
    if (grid == 0) {
        if (n_in != 21 || (size_t)out_size != OUT_TOTAL || ws_size < WS_END) { fprintf(stderr, "kernel_launch: unexpected shapes: n_in %d out %d ws %zu (need %zu)\n", n_in, out_size, ws_size, (size_t)WS_END); grid = -1; return; }
        int dev = 0, cus = 0;
        if (hipGetDevice(&dev) != hipSuccess || hipDeviceGetAttribute(&cus, hipDeviceAttributeMultiprocessorCount, dev) != hipSuccess) { fprintf(stderr, "kernel_launch: device query failed\n"); grid = -1; return; }
        if (hipFuncSetAttribute((const void*)mk_fwd, hipFuncAttributeMaxDynamicSharedMemorySize, LDS_BYTES) != hipSuccess) { fprintf(stderr, "kernel_launch: hipFuncSetAttribute failed\n"); grid = -1; return; }
        (void)hipGetLastError();
        grid = cus;
    }
    if (grid < 0) return;
    if (hipMemsetAsync((char*)d_ws + WS_CTL, 0, CTL_ZERO_BYTES, stream) != hipSuccess) { fprintf(stderr, "kernel_launch: memset failed\n"); return; }
    Args a{};
    for (int i = 0; i < 21; ++i) a.in[i] = (const float*)d_in[i];
    a.out = (float*)d_out; a.ws = (unsigned char*)d_ws;
#if MK_ONE_LAUNCH
    a.ph_lo = 0; a.ph_hi = N_PHASES;
    hipLaunchKernelGGL(mk_fwd, dim3(grid), dim3(NWAVES * 64), LDS_BYTES, stream, a);
#else
    for (int ph = 0; ph < N_PHASES; ++ph) { a.ph_lo = ph; a.ph_hi = ph + 1; hipLaunchKernelGGL(mk_fwd, dim3(grid), dim3(NWAVES * 64), LDS_BYTES, stream, a); }
#endif
    const hipError_t le = hipPeekAtLastError();
    if (le != hipSuccess) fprintf(stderr, "kernel_launch: launch failed: %s\n", hipGetErrorName(le));
}
```
